# Optimizing an MI355X kernel written in HIP

```python
import jax, jax.numpy as jnp
from jax import lax
import numpy as np

D_MODEL = 2048
BATCH = 32
SEQ = 256
DEPTH = 4
DEC_BATCH = 4
DEC_SEQ = 1024
PAST_LEN = 512

GRID_W = 64
H_RET = 8
DK_RET = 128
DV_RET = 128
D_RET = H_RET * DV_RET
H_ATT = 8
H_KV = 2
G_ATT = H_ATT // H_KV
DH_ATT = 128
D_ATT = H_ATT * DH_ATT
D_MIX = D_RET + D_ATT
D_IN = 2 * H_RET * DK_RET + 2 * H_RET * DV_RET + H_ATT * DH_ATT + 2 * H_KV * DH_ATT
WINDOW = 128
BLOCK = 128
D_FF = 5632
CONV_W = 3
N_MOD = 6
ROPE_BASE = 10000.0
EPS = 1e-6
NEG_INF = -1e30

kernel_name = "hybrid_retention_swa_prefix_dit_step"


def rms_norm(x):
    xf = x.astype(jnp.float32)
    return (xf * lax.rsqrt(jnp.mean(xf * xf, axis=-1, keepdims=True) + EPS)).astype(x.dtype)


def modulation(cond, w_mod_l, b_mod_l):
    m = jax.nn.silu(cond) @ w_mod_l + b_mod_l
    return jnp.split(m[..., None, :], N_MOD, axis=-1)


def modulate(x, shift, scale):
    return rms_norm(x) * (1 + scale) + shift


def project(h, w_in_l):
    B, T, _ = h.shape
    sizes = (H_RET * DK_RET, H_RET * DK_RET, H_RET * DV_RET, H_RET * DV_RET,
             H_ATT * DH_ATT, H_KV * DH_ATT, H_KV * DH_ATT)
    cuts = [int(s) for s in np.cumsum(sizes)[:-1]]
    q_r, k_r, v_r, g_r, q_a, k_a, v_a = jnp.split(h @ w_in_l, cuts, axis=-1)
    heads = lambda t, n: t.reshape(B, T, n, -1).transpose(0, 2, 1, 3)
    q_a = q_a.reshape(B, T, H_KV, G_ATT, DH_ATT).transpose(0, 2, 3, 1, 4)
    return (heads(q_r, H_RET), heads(k_r, H_RET), heads(v_r, H_RET), g_r,
            q_a, heads(k_a, H_KV), heads(v_a, H_KV))


def retention_scan(q, k, v, log_gamma, s0):
    B, H, T, DK = q.shape
    DV = v.shape[-1]
    N = T // BLOCK
    q = q.astype(jnp.float32).reshape(B, H, N, BLOCK, DK)
    k = (k.astype(jnp.float32) * DK ** -0.5).reshape(B, H, N, BLOCK, DK)
    v = v.astype(jnp.float32).reshape(B, H, N, BLOCK, DV)
    lg = log_gamma.astype(jnp.float32)
    idx = jnp.arange(BLOCK, dtype=jnp.float32)
    diff = idx[:, None] - idx[None, :]
    intra_decay = jnp.where(diff >= 0, jnp.exp(lg[:, None, None] * jnp.maximum(diff, 0.0)), 0.0)
    scores = jnp.einsum('bhncd,bhnsd->bhncs', q, k) * intra_decay[:, None]
    o_intra = jnp.einsum('bhncs,bhnse->bhnce', scores, v)
    q_dec = jnp.exp(lg[:, None] * (idx + 1.0))
    k_dec = jnp.exp(lg[:, None] * (BLOCK - 1.0 - idx))
    c_dec = jnp.exp(lg * BLOCK)[None, :, None, None]
    kv = jnp.einsum('bhncd,bhnce->nbhde', k * k_dec[:, None, :, None], v)
    qx = jnp.moveaxis(q * q_dec[:, None, :, None], 2, 0)

    def step(s, inp):
        qn, kvn = inp
        return c_dec * s + kvn, jnp.einsum('bhcd,bhde->bhce', qn, s)

    s_fin, o_cross = lax.scan(step, s0.astype(jnp.float32), (qx, kv))
    o = o_intra + jnp.moveaxis(o_cross, 0, 2)
    return o.reshape(B, H, T, DV), s_fin


def bidir_retention(q, k, v, lg_f, lg_b, s0_f, s0_b):
    o_f, s_f = retention_scan(q, k, v, lg_f, s0_f)
    o_b, s_b = retention_scan(jnp.flip(q, 2), jnp.flip(k, 2), jnp.flip(v, 2), lg_b, s0_b)
    return o_f + jnp.flip(o_b, 2), s_f, s_b


def retention_output(o, g, gn_l):
    B, H, T, DV = o.shape
    o = o.transpose(0, 2, 1, 3)
    mu = jnp.mean(o, axis=-1, keepdims=True)
    var = jnp.mean((o - mu) ** 2, axis=-1, keepdims=True)
    on = ((o - mu) * lax.rsqrt(var + EPS)).reshape(B, T, H * DV) * gn_l.astype(jnp.float32)
    return jax.nn.silu(g) * on.astype(g.dtype)


def sink_attend(q_blk, ks, vs, masks, sink):
    scale = DH_ATT ** -0.5
    scores = []
    for k, m in zip(ks, masks):
        s = jnp.einsum('bhgqd,bhkd->bhgqk', q_blk, k).astype(jnp.float32) * scale
        scores.append(s if m is None else jnp.where(m, s, NEG_INF))
    B, _, _, Q, _ = q_blk.shape
    sink_col = jnp.broadcast_to(sink.astype(jnp.float32)[None, :, :, None, None], (B, H_KV, G_ATT, Q, 1))
    p = jax.nn.softmax(jnp.concatenate([sink_col] + scores, axis=-1), axis=-1)
    out = None
    off = 1
    for v, s in zip(vs, scores):
        n = s.shape[-1]
        term = jnp.einsum('bhgqk,bhkd->bhgqd', p[..., off:off + n].astype(v.dtype), v)
        out = term if out is None else out + term
        off += n
    return out


def context_attention(q, k, v, sink):
    B, _, _, S, _ = q.shape

    def blk(i):
        qb = lax.dynamic_slice_in_dim(q, i * BLOCK, BLOCK, axis=3)
        return sink_attend(qb, [k], [v], [None], sink)

    o = lax.map(blk, jnp.arange(S // BLOCK))
    return jnp.moveaxis(o, 0, 3).reshape(B, H_KV, G_ATT, S, DH_ATT)


def latent_attention(q, k, v, ck, cv, sink):
    B, _, _, T, _ = q.shape
    pad = ((0, 0), (0, 0), (WINDOW, WINDOW), (0, 0))
    kp, vp = jnp.pad(k, pad), jnp.pad(v, pad)
    span = BLOCK + 2 * WINDOW
    a = jnp.arange(BLOCK)
    b = jnp.arange(span)
    rel = b[None, :] - a[:, None]

    def blk(i):
        start = i * BLOCK
        qb = lax.dynamic_slice_in_dim(q, start, BLOCK, axis=3)
        kb = lax.dynamic_slice_in_dim(kp, start, span, axis=2)
        vb = lax.dynamic_slice_in_dim(vp, start, span, axis=2)
        key_pos = start - WINDOW + b
        mask = (rel >= 0) & (rel <= 2 * WINDOW) & ((key_pos >= 0) & (key_pos < T))[None, :]
        return sink_attend(qb, [kb, ck], [vb, cv], [mask, None], sink)

    o = lax.map(blk, jnp.arange(T // BLOCK))
    return jnp.moveaxis(o, 0, 3).reshape(B, H_KV, G_ATT, T, DH_ATT)


def axial_angles(T):
    rows = T // GRID_W
    row = jnp.repeat(jnp.arange(rows), GRID_W)
    col = jnp.tile(jnp.arange(GRID_W), rows)
    n = DH_ATT // 4
    inv = ROPE_BASE ** (-jnp.arange(n, dtype=jnp.float32) / n)
    return row[:, None] * inv, col[:, None] * inv


def apply_axial_rope(x, ang_r, ang_c):
    half = x.shape[-1] // 2

    def rot(xh, ang):
        x1, x2 = jnp.split(xh, 2, axis=-1)
        c, s = jnp.cos(ang).astype(x.dtype), jnp.sin(ang).astype(x.dtype)
        return jnp.concatenate([x1 * c - x2 * s, x2 * c + x1 * s], axis=-1)

    return jnp.concatenate([rot(x[..., :half], ang_r), rot(x[..., half:], ang_c)], axis=-1)


def conv_ffn(h, w_up_l, conv_w_l, conv_b_l, w_down_l):
    T = h.shape[1]
    up = jnp.pad(h @ w_up_l, ((0, 0), ((CONV_W - 1) // 2, (CONV_W - 1) // 2), (0, 0)))
    u = conv_b_l + sum(up[:, j:j + T] * conv_w_l[j] for j in range(CONV_W))
    gate, val = jnp.split(u, 2, axis=-1)
    return (jax.nn.silu(gate) * val) @ w_down_l


def trunk_layer(x, mod, w_in_l, w_out_l, log_decay_l, gn_l, sink_l, w_up_l, conv_w_l, conv_b_l,
                w_down_l, ctx_k=None, ctx_v=None, ctx_state=None, rope=None):
    shift1, scale1, gate1, shift2, scale2, gate2 = mod
    B, T, _ = x.shape
    q_r, k_r, v_r, g_r, q_a, k_a, v_a = project(modulate(x, shift1, scale1), w_in_l)
    sink = sink_l.reshape(H_KV, G_ATT)
    if ctx_state is None:
        s0 = jnp.zeros((2, B, H_RET, DK_RET, DV_RET), jnp.float32)
    else:
        s0 = jnp.moveaxis(ctx_state, 1, 0)
    o_r, s_f, s_b = bidir_retention(q_r, k_r, v_r, log_decay_l[0], log_decay_l[1], s0[0], s0[1])
    y_r = retention_output(o_r, g_r, gn_l)
    if ctx_k is None:
        o_a = context_attention(q_a, k_a, v_a, sink)
    else:
        ang_r, ang_c = rope
        q_a = apply_axial_rope(q_a, ang_r, ang_c)
        k_a = apply_axial_rope(k_a, ang_r, ang_c)
        o_a = latent_attention(q_a, k_a, v_a, ctx_k, ctx_v, sink)
    y_a = o_a.transpose(0, 3, 1, 2, 4).reshape(B, T, D_ATT)
    x = x + gate1 * (jnp.concatenate([y_r, y_a], axis=-1) @ w_out_l)
    x = x + gate2 * conv_ffn(modulate(x, shift2, scale2), w_up_l, conv_w_l, conv_b_l, w_down_l)
    return x, k_a, v_a, jnp.stack([s_f, s_b], axis=1)


def setup_inputs(seed: int = 0) -> dict:
    key = jax.random.key(seed)
    ks = jax.random.split(key, 20)
    f32 = jnp.float32
    nrm = lambda k, shape, s: jax.random.normal(k, shape, f32) * s
    base_decay = jnp.log1p(-(2.0 ** (-5.0 - jnp.arange(H_RET, dtype=f32))))
    return {
        "x_prompt": nrm(ks[0], (BATCH, SEQ, D_MODEL), 1.0),
        "x_sample": nrm(ks[1], (DEC_BATCH, DEC_SEQ, D_MODEL), 1.0),
        "cache_k": nrm(ks[2], (DEC_BATCH, DEPTH, H_KV, PAST_LEN, DH_ATT), 1.0),
        "cache_v": nrm(ks[3], (DEC_BATCH, DEPTH, H_KV, PAST_LEN, DH_ATT), 1.0),
        "state_ret": nrm(ks[4], (DEC_BATCH, DEPTH, 2, H_RET, DK_RET, DV_RET), 0.1),
        "c": nrm(ks[5], (DEC_BATCH, D_MODEL), 1.0),
        "c_ctx": nrm(ks[6], (D_MODEL,), 1.0),
        "w_mod": nrm(ks[7], (DEPTH, D_MODEL, N_MOD * D_MODEL), 0.5 * D_MODEL ** -0.5),
        "b_mod": nrm(ks[8], (DEPTH, N_MOD * D_MODEL), 0.02),
        "w_in": nrm(ks[9], (DEPTH, D_MODEL, D_IN), D_MODEL ** -0.5),
        "w_out": nrm(ks[10], (DEPTH, D_MIX, D_MODEL), D_MIX ** -0.5),
        "ret_log_decay": base_decay * (1.0 + nrm(ks[11], (DEPTH, 2, H_RET), 0.05)),
        "ret_gn": 1.0 + nrm(ks[12], (DEPTH, D_RET), 0.02),
        "att_sink": nrm(ks[13], (DEPTH, H_ATT), 0.5),
        "w_up": nrm(ks[14], (DEPTH, D_MODEL, 2 * D_FF), D_MODEL ** -0.5),
        "conv_w": nrm(ks[15], (DEPTH, CONV_W, 2 * D_FF), CONV_W ** -0.5),
        "conv_b": nrm(ks[16], (DEPTH, 2 * D_FF), 0.02),
        "w_down": nrm(ks[17], (DEPTH, D_FF, D_MODEL), D_FF ** -0.5),
        "final_gain": 1.0 + nrm(ks[18], (D_MODEL,), 0.02),
    }


def reference(x_prompt, x_sample, cache_k, cache_v, state_ret, c, c_ctx, w_mod, b_mod, w_in, w_out,
              ret_log_decay, ret_gn, att_sink, w_up, conv_w, conv_b, w_down, final_gain):
    rope = axial_angles(x_sample.shape[1])
    xp, xs = x_prompt, x_sample
    new_k, new_v, new_s = [], [], []
    for l in range(DEPTH):
        weights = (w_in[l], w_out[l], ret_log_decay[l], ret_gn[l], att_sink[l],
                   w_up[l], conv_w[l], conv_b[l], w_down[l])
        xp, k_l, v_l, s_l = trunk_layer(xp, modulation(c_ctx, w_mod[l], b_mod[l]), *weights)
        new_k.append(k_l)
        new_v.append(v_l)
        new_s.append(s_l)
        xs, _, _, _ = trunk_layer(xs, modulation(c, w_mod[l], b_mod[l]), *weights,
                                  ctx_k=cache_k[:, l], ctx_v=cache_v[:, l],
                                  ctx_state=state_ret[:, l], rope=rope)
    y_prompt = rms_norm(xp) * final_gain
    y_sample = rms_norm(xs) * final_gain
    new_cache_k = jnp.stack(new_k, axis=1)
    new_cache_v = jnp.stack(new_v, axis=1)
    new_state_ret = jnp.stack(new_s, axis=1)
    return (y_prompt, y_sample, new_cache_k, new_cache_v, new_state_ret)
```

```cpp
#include <hip/hip_runtime.h>
#include <cstdio>
#include <cstdint>
namespace pg8 {
#define PG8_LAS __attribute__((address_space(3)))
typedef unsigned short bf16_t;
typedef short bf16x8 __attribute__((ext_vector_type(8)));
typedef float f32x4 __attribute__((ext_vector_type(4)));
typedef unsigned u32x4 __attribute__((ext_vector_type(4)));
constexpr int BM = 256, BK = 64, HALF = 128, HTB = HALF * BK * 2  , STAGE_BYTES = 8 * HTB, NXCD = 8, WGM = 8;

__host__ __device__ __forceinline__ int lds_byte(int r, int c) { const int st = (r >> 4) * 2 + (c >> 5), rr = r & 15, cc = c & 31, ob = rr * 64 + cc * 2; return st * 1024 + (ob ^ (((ob >> 9) & 1) << 5)); }
__host__ __device__ __forceinline__ void stage_rc(int b, int& R, int& C) { const int st = b / 1024, sb = b % 1024, swz = sb ^ (((sb >> 9) & 1) << 5); R = (st >> 1) * 16 + swz / 64; C = (st & 1) * 32 + (swz % 64) / 2; }
__host__ __device__ __forceinline__ int perm32(int rho) { const int n = rho >> 4, i = rho & 15; return 8 * (i >> 2) + 4 * n + (i & 3); }

struct Unit { int pm, pn; };
struct Gemm { const bf16_t* A; const bf16_t* Bt; int M, N, K; };

struct StaticOrder {
    int nM, nN, nwg, G, c;
    __host__ __device__ void init(int M, int N, int G_, int c_) { nM = M / BM; nN = N / BM; nwg = nM * nN; G = G_; c = c_; }
    __host__ __device__ bool next(int i, Unit& u) const {
        const long L = (long)i * G + c; if (L >= nwg) return false;
        int wgid = (int)L; { const int q = nwg / NXCD, r = nwg % NXCD, xcd = wgid % NXCD, off = wgid / NXCD; wgid = (xcd < r ? xcd * (q + 1) : r * (q + 1) + (xcd - r) * q) + off; }
        const int nig = WGM * nN, gid = wgid / nig, fm = gid * WGM, gsz = (nM - fm) < WGM ? (nM - fm) : WGM;
        u.pm = fm + ((wgid % nig) % gsz); u.pn = (wgid % nig) / gsz; return true;
    }
    __device__ __forceinline__ void a_ready(const Unit&) const {}
    __device__ __forceinline__ void done(const Unit&) const {}
};
__device__ __forceinline__ unsigned cvt_pk_bf16(float lo, float hi) { unsigned r; asm volatile("v_cvt_pk_bf16_f32 %0, %1, %2" : "=v"(r) : "v"(lo), "v"(hi)); return r; }
template <class Epi, class Sched, bool ALIGN_EPI = false, bool SP2 = false>
__device__ __forceinline__ void gemm_phase(PG8_LAS unsigned char* lds, const Gemm g, const Sched& S, const Epi& E) {
    int tid_ = threadIdx.x; asm volatile("" : "+v"(tid_));
    const int tid = tid_, wid = __builtin_amdgcn_readfirstlane(tid >> 6), lane = tid & 63, wr = wid >> 2, wc = wid & 3, fr = lane & 15, fq = lane >> 4;
    const int K = g.K, nt = K / BK;
    unsigned voffA[2], voffB[2];
#pragma unroll
    for (int i = 0; i < 2; ++i) { int R, C; stage_rc(tid * 16 + i * 8192, R, C); const int Rb = Epi::PERM ? ((R & ~31) + perm32(R & 31)) : R;
        voffA[i] = (unsigned)(R * K + C) * 2u; voffB[i] = (unsigned)(Rb * K + C) * 2u; }
    const size_t kstep = (size_t)(BK * 2);
    const size_t hstep = (size_t)HALF * K * 2;
    const size_t tstep = 2 * hstep;
    const unsigned ldsw = (unsigned)wid * 1024u;
    const int aoff = lds_byte(wr * 64 + fr, fq * 8), boff = lds_byte(wc * 32 + fr, fq * 8);
#define PG8_SA(b, h) (((b) * 2 + (h)) * HTB)
#define PG8_SB(b, h) ((4 + (b) * 2 + (h)) * HTB)
#define PG8_STAGE(bufoff, gbase, voff) do { _Pragma("unroll") for (int _i = 0; _i < 2; ++_i) \
        __builtin_amdgcn_global_load_lds((const unsigned*)((const char*)(gbase) + (voff)[_i]), (PG8_LAS unsigned*)(lds + (bufoff) + ldsw + _i * 8192), 16, 0, 0); } while (0)
#define PG8_LDA(dst, b, h) do { _Pragma("unroll") for (int m = 0; m < 4; ++m) _Pragma("unroll") for (int k = 0; k < 2; ++k) dst[m][k] = *(const PG8_LAS bf16x8*)(lds + PG8_SA(b, h) + aoff + m * 2048 + k * 1024); } while (0)
#define PG8_LDB(dst, b, h) do { _Pragma("unroll") for (int n = 0; n < 2; ++n) _Pragma("unroll") for (int k = 0; k < 2; ++k) dst[n][k] = *(const PG8_LAS bf16x8*)(lds + PG8_SB(b, h) + boff + n * 2048 + k * 1024); } while (0)
#define PG8_MMA(ai, bj, At, Bt) do { __builtin_amdgcn_s_setprio(1); _Pragma("unroll") for (int m = 0; m < 4; ++m) _Pragma("unroll") for (int n = 0; n < 2; ++n) _Pragma("unroll") for (int k = 0; k < 2; ++k) \
        acc[ai][bj][m][n] = __builtin_amdgcn_mfma_f32_16x16x32_bf16(Bt[n][k], At[m][k], acc[ai][bj][m][n], 0, 0, 0); __builtin_amdgcn_s_setprio(0); } while (0)
#define PG8_WAIT_V(n) asm volatile("s_waitcnt vmcnt(" #n ")" ::: "memory")
#define PG8_WAIT_L(n) asm volatile("s_waitcnt lgkmcnt(" #n ")" ::: "memory")
#define PG8_BAR __builtin_amdgcn_s_barrier()
#define PG8_SCHED __builtin_amdgcn_sched_barrier(0)
    Unit cur, nxt; int ui = 0;
    if (!S.next(0, cur)) return;
    f32x4 acc[2][2][4][2];
#pragma unroll
    for (int a = 0; a < 2; ++a)
#pragma unroll
        for (int b = 0; b < 2; ++b)
#pragma unroll
            for (int m = 0; m < 4; ++m)
#pragma unroll
                for (int n = 0; n < 2; ++n) acc[a][b][m][n] = (f32x4){0.f, 0.f, 0.f, 0.f};
    bf16x8 At[4][2], B0[2][2], B1[2][2];
    const char* cA = (const char*)g.A + (size_t)cur.pm * tstep; const char* cB = (const char*)g.Bt + (size_t)cur.pn * tstep;
    S.a_ready(cur);
    if constexpr (SP2) {
        PG8_STAGE(PG8_SB(0, 0), cB, voffB); PG8_STAGE(PG8_SB(0, 1), cB + hstep, voffB); PG8_STAGE(PG8_SA(0, 0), cA, voffA); PG8_STAGE(PG8_SA(0, 1), cA + hstep, voffA);
        if (wr == 1) PG8_BAR;
        PG8_WAIT_V(2); PG8_BAR;
        PG8_STAGE(PG8_SB(1, 0), cB + kstep, voffB); PG8_STAGE(PG8_SA(1, 0), cA + kstep, voffA); PG8_STAGE(PG8_SB(1, 1), cB + hstep + kstep, voffB);
        PG8_WAIT_V(6); PG8_BAR;
    } else {
        PG8_STAGE(PG8_SB(0, 0), cB, voffB); PG8_STAGE(PG8_SA(0, 0), cA, voffA); PG8_STAGE(PG8_SB(0, 1), cB + hstep, voffB); PG8_STAGE(PG8_SA(0, 1), cA + hstep, voffA);
        if (wr == 1) PG8_BAR;
        PG8_WAIT_V(4); PG8_BAR;
        PG8_STAGE(PG8_SB(1, 0), cB + kstep, voffB); PG8_STAGE(PG8_SA(1, 0), cA + kstep, voffA); PG8_STAGE(PG8_SB(1, 1), cB + hstep + kstep, voffB);
        PG8_WAIT_V(6); PG8_BAR;
    }
    for (;;) {
        const bool has_next = S.next(ui + 1, nxt);
        const char* nA = has_next ? (const char*)g.A + (size_t)nxt.pm * tstep : cA; const char* nB = has_next ? (const char*)g.Bt + (size_t)nxt.pn * tstep : cB;
        for (int t = 0; t < nt; t += 2) {
            const bool last = (t == nt - 2);
            const char* a1 = cA + (size_t)(t + 1) * kstep;
            const char* a2 = last ? nA : cA + (size_t)(t + 2) * kstep; const char* b2 = last ? nB : cB + (size_t)(t + 2) * kstep;
            const char* a3 = a2 + kstep; const char* b3 = b2 + kstep;
            if (last && has_next) S.a_ready(nxt);
            if constexpr (SP2) {
            PG8_LDB(B0, 0, 0); PG8_LDB(B1, 0, 1); PG8_SCHED; PG8_LDA(At, 0, 0); PG8_STAGE(PG8_SA(1, 1), a1 + hstep, voffA);
            PG8_WAIT_V(8); PG8_WAIT_L(0); PG8_BAR; PG8_MMA(0, 0, At, B0); PG8_MMA(0, 1, At, B1); PG8_BAR; PG8_SCHED;
            PG8_LDA(At, 0, 1); PG8_STAGE(PG8_SB(0, 0), b2, voffB); PG8_STAGE(PG8_SB(0, 1), b2 + hstep, voffB); PG8_STAGE(PG8_SA(0, 0), a2, voffA);
            PG8_WAIT_V(8); PG8_WAIT_L(0); PG8_BAR; PG8_MMA(1, 0, At, B0); PG8_MMA(1, 1, At, B1); PG8_BAR; PG8_SCHED;
            PG8_LDB(B0, 1, 0); PG8_LDB(B1, 1, 1); PG8_SCHED; PG8_LDA(At, 1, 0); PG8_STAGE(PG8_SA(0, 1), a2 + hstep, voffA);
            PG8_WAIT_V(8); PG8_WAIT_L(0); PG8_BAR; PG8_MMA(0, 0, At, B0); PG8_MMA(0, 1, At, B1); PG8_BAR; PG8_SCHED;
            PG8_LDA(At, 1, 1); PG8_STAGE(PG8_SB(1, 0), b3, voffB); PG8_STAGE(PG8_SB(1, 1), b3 + hstep, voffB); PG8_STAGE(PG8_SA(1, 0), a3, voffA);
            PG8_WAIT_V(8); PG8_WAIT_L(0); PG8_BAR; PG8_MMA(1, 0, At, B0); PG8_MMA(1, 1, At, B1); PG8_BAR; PG8_SCHED;
            } else {
            PG8_LDB(B0, 0, 0); PG8_SCHED; PG8_LDA(At, 0, 0); PG8_STAGE(PG8_SA(1, 1), a1 + hstep, voffA);
            PG8_WAIT_L(8); PG8_BAR; PG8_WAIT_L(0); PG8_MMA(0, 0, At, B0); PG8_BAR; PG8_SCHED;
            PG8_LDB(B1, 0, 1); PG8_STAGE(PG8_SB(0, 0), b2, voffB);
            PG8_BAR; PG8_WAIT_L(0); PG8_MMA(0, 1, At, B1); PG8_BAR;
            PG8_LDA(At, 0, 1); PG8_STAGE(PG8_SA(0, 0), a2, voffA);
            PG8_BAR; PG8_WAIT_L(0); PG8_MMA(1, 0, At, B0); PG8_BAR; PG8_SCHED;
            PG8_STAGE(PG8_SB(0, 1), b2 + hstep, voffB);
            PG8_WAIT_V(6); PG8_BAR; PG8_MMA(1, 1, At, B1); PG8_BAR;
            PG8_LDB(B0, 1, 0); PG8_SCHED; PG8_LDA(At, 1, 0); PG8_STAGE(PG8_SA(0, 1), a2 + hstep, voffA);
            PG8_WAIT_L(8); PG8_BAR; PG8_WAIT_L(0); PG8_MMA(0, 0, At, B0); PG8_BAR; PG8_SCHED;
            PG8_LDB(B1, 1, 1); PG8_STAGE(PG8_SB(1, 0), b3, voffB);
            PG8_BAR; PG8_WAIT_L(0); PG8_MMA(0, 1, At, B1); PG8_BAR;
            PG8_LDA(At, 1, 1); PG8_STAGE(PG8_SA(1, 0), a3, voffA);
            PG8_BAR; PG8_WAIT_L(0); PG8_MMA(1, 0, At, B0); PG8_BAR; PG8_SCHED;
            PG8_STAGE(PG8_SB(1, 1), b3 + hstep, voffB);
            PG8_WAIT_V(6); PG8_BAR; PG8_MMA(1, 1, At, B1); PG8_BAR;
            }
        }
        if constexpr (ALIGN_EPI) { if (wr == 0) PG8_BAR; }
        if constexpr (!Epi::AFTER_DRAIN) { E(acc, cur, wr, wc, fr, fq); S.done(cur); }
        if (!has_next) break;
#pragma unroll
        for (int a = 0; a < 2; ++a)
#pragma unroll
            for (int b = 0; b < 2; ++b)
#pragma unroll
                for (int m = 0; m < 4; ++m)
#pragma unroll
                    for (int n = 0; n < 2; ++n) acc[a][b][m][n] = (f32x4){0.f, 0.f, 0.f, 0.f};
        cur = nxt; cA = nA; cB = nB; ++ui;
        if constexpr (ALIGN_EPI) { if (wr == 1) PG8_BAR; }
    }
    PG8_WAIT_V(0);
    if constexpr (!ALIGN_EPI) { if (wr == 0) PG8_BAR; }
    PG8_BAR;
    if constexpr (Epi::AFTER_DRAIN) { E.fused(acc, cur, wr, wc, fr, fq, lds, wid, lane); S.done(cur); }
#undef PG8_SA
#undef PG8_SB
#undef PG8_STAGE
#undef PG8_LDA
#undef PG8_LDB
#undef PG8_MMA
#undef PG8_WAIT_V
#undef PG8_WAIT_L
#undef PG8_BAR
#undef PG8_SCHED
}
}

#define GAS __attribute__((address_space(1)))
#define LAS __attribute__((address_space(3)))
typedef unsigned short bf16;
typedef unsigned v4u __attribute__((ext_vector_type(4)));
typedef float f32x4 __attribute__((ext_vector_type(4)));
typedef short bf16x8 __attribute__((ext_vector_type(8)));
typedef GAS unsigned gu32;
typedef GAS unsigned long long gu64;
#define RLX_AGENT __ATOMIC_RELAXED, __HIP_MEMORY_SCOPE_AGENT
#define LDS_WAIT() asm volatile("s_waitcnt lgkmcnt(0)" ::: "memory")
#define VM_WAIT() asm volatile("s_waitcnt vmcnt(0)" ::: "memory")
__device__ __forceinline__ unsigned long long rt() { return __builtin_amdgcn_s_memrealtime(); }
__device__ __forceinline__ unsigned f2bf(float f) { unsigned u = __builtin_bit_cast(unsigned, f); return (u + 0x7fffu + ((u >> 16) & 1u)) >> 16; }
__device__ __forceinline__ unsigned pk2(float lo, float hi) { return f2bf(lo) | (f2bf(hi) << 16); }
#define XB_TMO      128
#define XB_XCNT(j)  (256  + 64 * (j))
#define XB_XSUB(j)  (1280 + 64 * (j))
#define XB_XGEN(j)  (2304 + 64 * (j))
#define XB_TOP      3328
#define XB_TOPGEN   3392
#define XCD_BAR_WORDS 3456
#define XB_SPIN_CAP (1u << 18)

__device__ __forceinline__ unsigned xb_ld(unsigned* p)              { return __hip_atomic_load(p, __ATOMIC_RELAXED, __HIP_MEMORY_SCOPE_AGENT); }
__device__ __forceinline__ unsigned xb_add(unsigned* p, unsigned v) { return __hip_atomic_fetch_add(p, v, __ATOMIC_RELAXED, __HIP_MEMORY_SCOPE_AGENT); }
__device__ __forceinline__ unsigned xb_xcc_id() { return (unsigned)__builtin_amdgcn_s_getreg((3 << 11) | 20) & 0xFu; }
#define XB_SPIN(cond, bar) do { unsigned _sp = 0; while (cond) { __builtin_amdgcn_s_sleep(1); \
    if ((++_sp & 255u) == 0u) { if (xb_ld(&(bar)[XB_TMO])) break; if (_sp > XB_SPIN_CAP) { atomicAdd(&(bar)[XB_TMO], 1u); break; } } } } while (0)

struct XcdBarrier {
    unsigned* bar; unsigned x;
    volatile LAS unsigned* st;
};

__device__ __forceinline__ XcdBarrier xcd_barrier_post(unsigned* bar, volatile LAS unsigned* st) {
    XcdBarrier b; b.bar = bar; b.x = xb_xcc_id(); b.st = st;
    if (threadIdx.x == 0) (void)xb_add(&bar[XB_XCNT(b.x)], 1u);
    return b;
}
__device__ __forceinline__ void xcd_barrier_complete(unsigned* bar, unsigned x, unsigned& nloc, unsigned& nx) {
    const unsigned G = gridDim.x * gridDim.y * gridDim.z;
    unsigned sum, cnt, mine, sp = 0u;
    for (;;) {
        sum = 0u; cnt = 0u; mine = 0u;
#pragma unroll
        for (unsigned j = 0; j < 16; ++j) { const unsigned c = xb_ld(&bar[XB_XCNT(j)]); sum += c; cnt += (c > 0u) ? 1u : 0u; mine = (j == x) ? c : mine; }
        if (sum == G) break;
        __builtin_amdgcn_s_sleep(1);
        if ((++sp & 255u) == 0u) { if (xb_ld(&bar[XB_TMO])) break; if (sp > XB_SPIN_CAP) { atomicAdd(&bar[XB_TMO], 1u); break; } }
    }
    nloc = mine > 0u ? mine : 1u; nx = cnt > 0u ? cnt : 1u;
}

__device__ __forceinline__ void xcd_barrier(const XcdBarrier& b) {
    asm volatile("s_waitcnt vmcnt(0)" ::: "memory");
    __syncthreads();
    if (threadIdx.x == 0) {
        unsigned* bar = b.bar;
        __builtin_amdgcn_s_waitcnt(0);
        unsigned nloc = b.st[0], nx = b.st[1];
        if (nloc == 0u) { xcd_barrier_complete(bar, b.x, nloc, nx); b.st[0] = nloc; b.st[1] = nx; }
        const unsigned old = xb_add(&bar[XB_XSUB(b.x)], 1u);
        const unsigned gen = old / nloc;
        if (old + 1u == (gen + 1u) * nloc) {
            __builtin_amdgcn_fence(__ATOMIC_RELEASE, "agent");
            asm volatile("s_waitcnt vmcnt(0)" ::: "memory");
            const unsigned og = xb_add(&bar[XB_TOP], 1u);
            const unsigned tg = og / nx;
            if (og + 1u == (tg + 1u) * nx) xb_add(&bar[XB_TOPGEN], 1u);
            else XB_SPIN(xb_ld(&bar[XB_TOPGEN]) == tg, bar);
            __builtin_amdgcn_fence(__ATOMIC_ACQUIRE, "agent");
            xb_add(&bar[XB_XGEN(b.x)], 1u);
            asm volatile("s_waitcnt vmcnt(0)" ::: "memory");
        } else {
            XB_SPIN(xb_ld(&bar[XB_XGEN(b.x)]) == gen, bar);
            __builtin_amdgcn_fence(__ATOMIC_ACQUIRE, "agent");
            asm volatile("s_waitcnt vmcnt(0)" ::: "memory");
        }
    }
    __syncthreads();
}

constexpr int DM = 2048, NB_P = 32, SEQ_P = 256, NB_S = 4, SEQ_S = 1024, PAST = 512, DEPTH = 4;
constexpr int MP = NB_P * SEQ_P, MS = NB_S * SEQ_S, MTOK = MP + MS;
constexpr int NHEAD = 8, HKV = 2, HD = 128;
constexpr int DIN = 5632, DFF = 5632, DUP = 2 * DFF, NMODC = 6 * DM;
constexpr int C_QR = 0, C_KR = 1024, C_VR = 2048, C_GR = 3072, C_QA = 4096, C_KA = 5120, C_VA = 5376;
constexpr int NCOND = 5;
constexpr float EPS = 1e-6f, LOG2E = 1.4426950408889634f;
constexpr float QK_SCALE = 0.08838834764831845f;
constexpr size_t OUT_Y = 0, OUT_CK = (size_t)MTOK * DM, OUT_CV = OUT_CK + (size_t)NB_P * DEPTH * HKV * SEQ_P * HD, OUT_ST = OUT_CV + (size_t)NB_P * DEPTH * HKV * SEQ_P * HD;
constexpr size_t OUT_TOTAL = OUT_ST + (size_t)NB_P * DEPTH * 2 * NHEAD * HD * HD;
constexpr size_t MiB = 1u << 20;
constexpr size_t WS_CTL = 0, CTL_ZERO_BYTES = 1 * MiB;
constexpr size_t WS_ROPE = 1 * MiB, WS_MOD = 2 * MiB, WS_MODP = 3 * MiB, WS_CKB = 18 * MiB, WS_CVB = 22 * MiB, WS_SRET = 26 * MiB;
constexpr size_t WS_WIN = 58 * MiB, WS_WOUT = 146 * MiB, WS_WUP = 178 * MiB, WS_WDN = 354 * MiB;
constexpr size_t WS_X = 442 * MiB, WS_H = 538 * MiB, WS_MIX = 586 * MiB, WS_ACT = 634 * MiB, WS_PROJ = 766 * MiB, WS_END = 1030 * MiB;
constexpr int KCH = 16;
constexpr int CW_BAR = 4096;
constexpr int LDS_BYTES = 147456;
constexpr int MISC_OFF = 131072 + 320;
constexpr int NWAVES = 8;

typedef unsigned v2u __attribute__((ext_vector_type(2)));
struct Args;
typedef const __attribute__((address_space(4))) Args* ArgP;
struct Args { const float* in[19]; float* out; unsigned char* ws; int ph_lo, ph_hi; };

__device__ __forceinline__ float wave_sum(float v) {
#pragma unroll
    for (int o = 1; o < 64; o <<= 1) v += __shfl_xor(v, o);
    return v;
}
struct Ids { int tid, lane, wave, bx, G, gw, NGW, gt, NGT; };
__device__ __forceinline__ Ids make_ids() {
    Ids I; int t = threadIdx.x; asm volatile("" : "+v"(t)); int bx = blockIdx.x, G = gridDim.x; asm volatile("" : "+s"(bx), "+s"(G));
    I.tid = t; I.lane = t & 63; I.wave = __builtin_amdgcn_readfirstlane(t >> 6); I.bx = bx; I.G = G;
    const int vcu = (G % 8 == 0) ? (bx % 8) * (G / 8) + bx / 8 : bx;
    I.gw = vcu * 8 + I.wave; I.NGW = G * 8; I.gt = I.gw * 64 + I.lane; I.NGT = I.NGW * 64; return I;
}
__device__ __forceinline__ ArgP launder(ArgP a) { asm volatile("" : "+s"(a)); return a; }
__device__ __forceinline__ float bf2f(unsigned short b) { return __builtin_bit_cast(float, (unsigned)b << 16); }
__device__ __forceinline__ float bflo(unsigned w) { return __builtin_bit_cast(float, w << 16); }
__device__ __forceinline__ float bfhi(unsigned w) { return __builtin_bit_cast(float, w & 0xffff0000u); }
__device__ __forceinline__ float silu_f(float x) { return x / (1.f + __expf(-x)); }
__device__ __forceinline__ int cond_of_row(int row) { return row < MP ? 0 : 1 + ((row - MP) >> 10); }

__device__ __forceinline__ void p0_transpose_item(const float* W, int K, int N, bf16* WT, LAS float* scr, int item, int lane) {
    const int nblk = N / 32, kb = item / nblk, nb = item % nblk, k0 = 64 * kb, n0 = 32 * nb;
#pragma unroll 8
    for (int i = 0; i < 32; ++i) { const int kk = 2 * i + (lane >> 5); scr[kk * 33 + (lane & 31)] = W[(size_t)(k0 + kk) * N + n0 + (lane & 31)]; }
    LDS_WAIT(); asm volatile("" ::: "memory");
    const int c = lane & 7;
#pragma unroll
    for (int j = 0; j < 4; ++j) { const int n = (lane >> 3) + 8 * j; const LAS float* s = scr + (8 * c) * 33 + n;
        v4u o; o.x = pk2(s[0 * 33], s[1 * 33]); o.y = pk2(s[2 * 33], s[3 * 33]); o.z = pk2(s[4 * 33], s[5 * 33]); o.w = pk2(s[6 * 33], s[7 * 33]);
        *(GAS v4u*)(WT + (size_t)(n0 + n) * K + k0 + 8 * c) = o; }
    LDS_WAIT(); asm volatile("" ::: "memory");
}

__device__ __forceinline__ void phase_prologue_a(ArgP a, LAS unsigned char* lds) {
    a = launder(a); const Ids I = make_ids(); const int tid = I.tid, lane = I.lane, wave = I.wave, gw = I.gw, NGW = I.NGW;
    unsigned char* ws = a->ws;
    LAS float* tab = (LAS float*)(lds + 73728);
    for (int i = tid; i < NCOND * DM; i += 512) { const int j = i / DM, k = i % DM; const float x = (j == 0) ? a->in[6][k] : a->in[5][(j - 1) * DM + k]; tab[i] = silu_f(x); }
    __syncthreads();
    LAS float* scr = (LAS float*)(lds + wave * 8704);
    constexpr int I_IN = (DM / 64) * (DIN / 32), I_OUT = (DM / 64) * (DM / 32), I_UP = (DM / 64) * (DUP / 32), I_DN = (DFF / 64) * (DM / 32), I_L = I_IN + I_OUT + I_UP + I_DN;
    for (int it = gw; it < DEPTH * I_L; it += NGW) {
        const int l = it / I_L; int r = it % I_L;
        if (r < I_IN) { p0_transpose_item(a->in[9] + (size_t)l * DM * DIN, DM, DIN, (bf16*)(ws + WS_WIN) + (size_t)l * DIN * DM, scr, r, lane); continue; } r -= I_IN;
        if (r < I_OUT) { p0_transpose_item(a->in[10] + (size_t)l * DM * DM, DM, DM, (bf16*)(ws + WS_WOUT) + (size_t)l * DM * DM, scr, r, lane); continue; } r -= I_OUT;
        if (r < I_UP) { p0_transpose_item(a->in[14] + (size_t)l * DM * DUP, DM, DUP, (bf16*)(ws + WS_WUP) + (size_t)l * DUP * DM, scr, r, lane); continue; } r -= I_UP;
        p0_transpose_item(a->in[17] + (size_t)l * DFF * DM, DFF, DM, (bf16*)(ws + WS_WDN) + (size_t)l * DM * DFF, scr, r, lane);
    }
    {
        float* modp = (float*)(ws + WS_MODP);
        constexpr int NCB = NMODC / 256;
        for (int it = gw; it < DEPTH * KCH * NCB; it += NGW) {
            const int cb = it % NCB, kc = (it / NCB) % KCH, l = it / (NCB * KCH);
            const float* W = a->in[7] + ((size_t)l * DM + (size_t)kc * 128) * NMODC + cb * 256 + lane * 4;
            f32x4 acc[NCOND];
#pragma unroll
            for (int j = 0; j < NCOND; ++j) acc[j] = (f32x4){0.f, 0.f, 0.f, 0.f};
#pragma unroll 8
            for (int k = 0; k < 128; ++k) { const f32x4 w = *(const GAS f32x4*)(W + (size_t)k * NMODC);
#pragma unroll
                for (int j = 0; j < NCOND; ++j) acc[j] += tab[j * DM + kc * 128 + k] * w; }
#pragma unroll
            for (int j = 0; j < NCOND; ++j) *(GAS f32x4*)(modp + ((size_t)(kc * DEPTH + l) * NCOND + j) * NMODC + cb * 256 + lane * 4) = acc[j];
        }
    }
    const int gt = gw * 64 + lane, NGT = NGW * 64;
    {
        float* rope = (float*)(ws + WS_ROPE);
        for (int i = gt; i < SEQ_S * 32; i += NGT) { const int t = i >> 5, k = i & 31;
            const float inv = exp2f(-(float)k * (13.287712379549449f / 32.f));
            const float rr = (float)(t >> 6) * inv * 0.15915494309189535f, rc = (float)(t & 63) * inv * 0.15915494309189535f;
            const float fr_ = rr - floorf(rr), fc_ = rc - floorf(rc);
            rope[t * 128 + k] = __builtin_amdgcn_cosf(fr_); rope[t * 128 + 32 + k] = __builtin_amdgcn_sinf(fr_);
            rope[t * 128 + 64 + k] = __builtin_amdgcn_cosf(fc_); rope[t * 128 + 96 + k] = __builtin_amdgcn_sinf(fc_); }
    }
    {
        constexpr int NC8 = NB_S * DEPTH * HKV * PAST * HD / 8;
        for (int i = gt; i < 2 * NC8; i += NGT) { const bool isk = i < NC8; const int j = isk ? i : i - NC8;
            const float* src = (isk ? a->in[2] : a->in[3]) + (size_t)j * 8; const f32x4 x0 = *(const GAS f32x4*)src, x1 = *(const GAS f32x4*)(src + 4);
            v4u o; o.x = pk2(x0[0], x0[1]); o.y = pk2(x0[2], x0[3]); o.z = pk2(x1[0], x1[1]); o.w = pk2(x1[2], x1[3]);
            *(GAS v4u*)((bf16*)(ws + (isk ? WS_CKB : WS_CVB)) + (size_t)j * 8) = o; }
    }
    {
        float* X = (float*)(ws + WS_X);
        constexpr int NP4 = MP * DM / 4, NS4 = MS * DM / 4;
        for (int i = gt; i < NP4 + NS4; i += NGT) { const f32x4 v = (i < NP4) ? ((const GAS f32x4*)a->in[0])[i] : ((const GAS f32x4*)a->in[1])[i - NP4]; ((GAS f32x4*)X)[i] = v; }
    }
}
__device__ __forceinline__ void phase_prologue_b(ArgP a) {
    a = launder(a); const Ids I = make_ids(); const int gt = I.gt, NGT = I.NGT;
    const float* modp = (const float*)(a->ws + WS_MODP); float* mod = (float*)(a->ws + WS_MOD);
    constexpr int N4 = DEPTH * NCOND * NMODC / 4;
    for (int i = gt; i < N4; i += NGT) { const int c4 = i % (NMODC / 4), lj = i / (NMODC / 4), l = lj / NCOND, j = lj % NCOND;
        f32x4 s = *(const GAS f32x4*)(a->in[8] + (size_t)l * NMODC + c4 * 4);
#pragma unroll
        for (int kc = 0; kc < KCH; ++kc) s += *(const GAS f32x4*)(modp + ((size_t)(kc * DEPTH + l) * NCOND + j) * NMODC + c4 * 4);
        *(GAS f32x4*)(mod + (size_t)lj * NMODC + c4 * 4) = s; }
}
__device__ __forceinline__ void phase_modulate(ArgP a, int l, int which  ) {
    a = launder(a); const Ids I = make_ids(); const int lane = I.lane, gw = I.gw, NGW = I.NGW;
    const float* X = (const float*)(a->ws + WS_X); bf16* H = (bf16*)(a->ws + WS_H);
    for (int m = gw; m < MTOK; m += NGW) {
        const float* mod = (const float*)(a->ws + WS_MOD) + (size_t)(l * NCOND + cond_of_row(m)) * NMODC + which * 3 * DM;
        const GAS f32x4* xr = (const GAS f32x4*)(X + (size_t)m * DM) + lane;
        f32x4 v[8]; float s = 0.f;
#pragma unroll
        for (int j = 0; j < 8; ++j) { v[j] = xr[64 * j]; s += (v[j].x * v[j].x + v[j].y * v[j].y) + (v[j].z * v[j].z + v[j].w * v[j].w); }
        const float r = 1.f / sqrtf(wave_sum(s) * (1.f / DM) + EPS);
        GAS unsigned long long* o8 = (GAS unsigned long long*)(H + (size_t)m * DM) + lane;
#pragma unroll
        for (int j = 0; j < 8; ++j) { const f32x4 sh = *(const GAS f32x4*)(mod + (lane + 64 * j) * 4), sc = *(const GAS f32x4*)(mod + DM + (lane + 64 * j) * 4);
            const f32x4 h = v[j] * r * (sc + 1.f) + sh;
            o8[64 * j] = (unsigned long long)pk2(h.x, h.y) | ((unsigned long long)pk2(h.z, h.w) << 32); }
    }
}
__device__ __forceinline__ void phase_final(ArgP a) {
    a = launder(a); const Ids I = make_ids(); const int lane = I.lane, gw = I.gw, NGW = I.NGW;
    const float* X = (const float*)(a->ws + WS_X); const float* gain = a->in[18];
    for (int m = gw; m < MTOK; m += NGW) {
        const GAS f32x4* xr = (const GAS f32x4*)(X + (size_t)m * DM) + lane;
        f32x4 v[8]; float s = 0.f;
#pragma unroll
        for (int j = 0; j < 8; ++j) { v[j] = xr[64 * j]; s += (v[j].x * v[j].x + v[j].y * v[j].y) + (v[j].z * v[j].z + v[j].w * v[j].w); }
        const float r = 1.f / sqrtf(wave_sum(s) * (1.f / DM) + EPS);
        GAS f32x4* o = (GAS f32x4*)(a->out + OUT_Y + (size_t)m * DM) + lane;
#pragma unroll
        for (int j = 0; j < 8; ++j) o[64 * j] = v[j] * r * *(const GAS f32x4*)(gain + (lane + 64 * j) * 4);
    }
}
namespace pg8 {
struct EpiPlain {
    static constexpr bool PERM = true, AFTER_DRAIN = false;
    bf16_t* O; int ldc;
    __device__ __forceinline__ void operator()(const f32x4 (&acc)[2][2][4][2], const Unit& u, int wr, int wc, int fr, int fq) const {
        const int row0 = u.pm * BM + wr * 64 + fr, col0 = u.pn * BM + wc * 32 + 8 * fq;
#pragma unroll
        for (int ai = 0; ai < 2; ++ai)
#pragma unroll
            for (int m = 0; m < 4; ++m) { bf16_t* rowp = O + (size_t)(row0 + ai * HALF + m * 16) * ldc + col0;
#pragma unroll
                for (int bj = 0; bj < 2; ++bj) { const f32x4 v0 = acc[ai][bj][m][0], v1 = acc[ai][bj][m][1];
                    u32x4 w; w.x = cvt_pk_bf16(v0[0], v0[1]); w.y = cvt_pk_bf16(v0[2], v0[3]); w.z = cvt_pk_bf16(v1[0], v1[1]); w.w = cvt_pk_bf16(v1[2], v1[3]);
                    *(u32x4*)(rowp + bj * HALF) = w; } }
    }
};
struct EpiIn {
    static constexpr bool PERM = true, AFTER_DRAIN = false;
    bf16_t* O; float* ck; float* cv; int layer;
    __device__ __forceinline__ void operator()(const f32x4 (&acc)[2][2][4][2], const Unit& u, int wr, int wc, int fr, int fq) const {
        const int row0 = u.pm * BM + wr * 64 + fr, col0 = u.pn * BM + wc * 32 + 8 * fq;
#pragma unroll
        for (int ai = 0; ai < 2; ++ai)
#pragma unroll
            for (int m = 0; m < 4; ++m) { bf16_t* rowp = O + (size_t)(row0 + ai * HALF + m * 16) * DIN + col0;
#pragma unroll
                for (int bj = 0; bj < 2; ++bj) { const f32x4 v0 = acc[ai][bj][m][0], v1 = acc[ai][bj][m][1];
                    u32x4 w; w.x = cvt_pk_bf16(v0[0], v0[1]); w.y = cvt_pk_bf16(v0[2], v0[3]); w.z = cvt_pk_bf16(v1[0], v1[1]); w.w = cvt_pk_bf16(v1[2], v1[3]);
                    *(u32x4*)(rowp + bj * HALF) = w; } }
        if (u.pn >= C_KA / BM && u.pm < MP / BM) {
            float* dst = (u.pn == C_KA / BM) ? ck : cv;
#pragma unroll
            for (int ai = 0; ai < 2; ++ai)
#pragma unroll
                for (int m = 0; m < 4; ++m) { const int row = row0 + ai * HALF + m * 16, b = row >> 8, s = row & 255;
#pragma unroll
                    for (int bj = 0; bj < 2; ++bj) { float* p = dst + ((((size_t)b * DEPTH + layer) * HKV + bj) * SEQ_P + s) * HD + wc * 32 + 8 * fq;
                        *(f32x4*)p = acc[ai][bj][m][0]; *(f32x4*)(p + 4) = acc[ai][bj][m][1]; } }
        }
    }
};
struct EpiRes {
    static constexpr bool PERM = false, AFTER_DRAIN = false;
    float* X; const float* gate;
    __device__ __forceinline__ void operator()(const f32x4 (&acc)[2][2][4][2], const Unit& u, int wr, int wc, int fr, int fq) const {
        const int row0 = u.pm * BM + wr * 64 + fr, col0 = u.pn * BM + wc * 32 + 4 * fq;
        const int cond = u.pm < MP / BM ? 0 : 1 + ((u.pm - MP / BM) >> 2);
        const float* g = gate + (size_t)cond * NMODC + col0;
        f32x4 gv[2][2];
#pragma unroll
        for (int bj = 0; bj < 2; ++bj)
#pragma unroll
            for (int n = 0; n < 2; ++n) gv[bj][n] = *(const f32x4*)(g + bj * HALF + n * 16);
#pragma unroll
        for (int ai = 0; ai < 2; ++ai)
#pragma unroll
            for (int m = 0; m < 4; ++m) { float* rowp = X + (size_t)(row0 + ai * HALF + m * 16) * DM + col0;
#pragma unroll
                for (int bj = 0; bj < 2; ++bj)
#pragma unroll
                    for (int n = 0; n < 2; ++n) { float* p = rowp + bj * HALF + n * 16; *(f32x4*)p = *(const f32x4*)p + gv[bj][n] * acc[ai][bj][m][n]; }
                asm volatile("" ::: "memory"); }
    }
};
}

__device__ __forceinline__ void unpack8(v4u w, float (&f)[8]) { f[0] = bflo(w.x); f[1] = bfhi(w.x); f[2] = bflo(w.y); f[3] = bfhi(w.y); f[4] = bflo(w.z); f[5] = bfhi(w.z); f[6] = bflo(w.w); f[7] = bfhi(w.w); }
__device__ __forceinline__ void phase_convgate(ArgP a, int l) {
    a = launder(a); const Ids I = make_ids(); const int lane = I.lane, gw = I.gw, NGW = I.NGW;
    const bf16* UP = (const bf16*)(a->ws + WS_PROJ); bf16* ACT = (bf16*)(a->ws + WS_ACT);
    const float* cw = a->in[15] + (size_t)l * 3 * DUP; const float* cb = a->in[16] + (size_t)l * DUP;
    constexpr int NCB = DFF / 512, NRB = MTOK / 16;
    for (int it = gw; it < NCB * NRB; it += NGW) {
        const int cbk = it % NCB, rb = it / NCB, row0 = rb * 16, c0 = cbk * 512 + lane * 8;
        const int seqlen = row0 < MP ? SEQ_P : SEQ_S;
        const bool has_prev = (row0 % seqlen) != 0, has_next = ((row0 + 16) % seqlen) != 0;
        float wg[3][8], wv[3][8], bg[8], bv[8];
#pragma unroll
        for (int j = 0; j < 3; ++j) { const f32x4 g0 = *(const GAS f32x4*)(cw + j * DUP + c0), g1 = *(const GAS f32x4*)(cw + j * DUP + c0 + 4), v0 = *(const GAS f32x4*)(cw + j * DUP + DFF + c0), v1 = *(const GAS f32x4*)(cw + j * DUP + DFF + c0 + 4);
#pragma unroll
            for (int e = 0; e < 4; ++e) { wg[j][e] = g0[e]; wg[j][4 + e] = g1[e]; wv[j][e] = v0[e]; wv[j][4 + e] = v1[e]; } }
        { const f32x4 g0 = *(const GAS f32x4*)(cb + c0), g1 = *(const GAS f32x4*)(cb + c0 + 4), v0 = *(const GAS f32x4*)(cb + DFF + c0), v1 = *(const GAS f32x4*)(cb + DFF + c0 + 4);
#pragma unroll
            for (int e = 0; e < 4; ++e) { bg[e] = g0[e]; bg[4 + e] = g1[e]; bv[e] = v0[e]; bv[4 + e] = v1[e]; } }
        float pg[8], pv[8], cg[8], cv[8], ng[8], nv[8];
        const v4u z = {0u, 0u, 0u, 0u};
        { const v4u a0 = has_prev ? *(const GAS v4u*)(UP + (size_t)(row0 - 1) * DUP + c0) : z, a1 = has_prev ? *(const GAS v4u*)(UP + (size_t)(row0 - 1) * DUP + DFF + c0) : z; unpack8(a0, pg); unpack8(a1, pv); }
        { const v4u a0 = *(const GAS v4u*)(UP + (size_t)row0 * DUP + c0), a1 = *(const GAS v4u*)(UP + (size_t)row0 * DUP + DFF + c0); unpack8(a0, cg); unpack8(a1, cv); }
        for (int r = 0; r < 16; ++r) {
            const int row = row0 + r; const bool nx = (r < 15) || has_next;
            const v4u a0 = nx ? *(const GAS v4u*)(UP + (size_t)(row + 1) * DUP + c0) : z, a1 = nx ? *(const GAS v4u*)(UP + (size_t)(row + 1) * DUP + DFF + c0) : z;
            unpack8(a0, ng); unpack8(a1, nv);
            float o[8];
#pragma unroll
            for (int e = 0; e < 8; ++e) { const float ug = bg[e] + wg[0][e] * pg[e] + wg[1][e] * cg[e] + wg[2][e] * ng[e]; const float uv = bv[e] + wv[0][e] * pv[e] + wv[1][e] * cv[e] + wv[2][e] * nv[e];
                o[e] = silu_f(ug) * uv; pg[e] = cg[e]; pv[e] = cv[e]; cg[e] = ng[e]; cv[e] = nv[e]; }
            v4u w; w.x = pk2(o[0], o[1]); w.y = pk2(o[2], o[3]); w.z = pk2(o[4], o[5]); w.w = pk2(o[6], o[7]);
            *(GAS v4u*)(ACT + (size_t)row * DFF + c0) = w;
        }
    }
}

__device__ __forceinline__ void rope_pair(float& x0, float& x1, const float* rope_t, int lane) {
    const int half = lane >> 5, i0 = (2 * lane) & 31; const bool first = (lane & 16) == 0;
    const float c0 = rope_t[half * 64 + i0], c1 = rope_t[half * 64 + i0 + 1], s0 = rope_t[half * 64 + 32 + i0], s1 = rope_t[half * 64 + 32 + i0 + 1];
    const float p0 = __shfl_xor(x0, 16), p1 = __shfl_xor(x1, 16);
    x0 = first ? x0 * c0 - p0 * s0 : x0 * c0 + p0 * s0;
    x1 = first ? x1 * c1 - p1 * s1 : x1 * c1 + p1 * s1;
}
__device__ __forceinline__ void phase_naive_attn(ArgP a, int l) {
    a = launder(a); const Ids I = make_ids(); const int lane = I.lane, gw = I.gw, NGW = I.NGW;
    const bf16* P = (const bf16*)(a->ws + WS_PROJ); bf16* MIX = (bf16*)(a->ws + WS_MIX);
    const float* rope = (const float*)(a->ws + WS_ROPE);
    const bf16* CK = (const bf16*)(a->ws + WS_CKB); const bf16* CV = (const bf16*)(a->ws + WS_CVB);
    for (int it = gw; it < MTOK * NHEAD; it += NGW) {
        const int row = it >> 3, head = it & 7, hkv = head >> 2;
        const unsigned qw = *(const GAS unsigned*)(P + (size_t)row * DIN + C_QA + head * HD + 2 * lane);
        float q0 = bflo(qw), q1 = bfhi(qw);
        float m = a->in[13][l * NHEAD + head], lsum = 1.f, o0 = 0.f, o1 = 0.f;
        if (row < MP) {
            const int b = row >> 8;
            for (int j = 0; j < SEQ_P; ++j) { const size_t kr = (size_t)(b * SEQ_P + j) * DIN;
                const unsigned kw = *(const GAS unsigned*)(P + kr + C_KA + hkv * HD + 2 * lane), vw = *(const GAS unsigned*)(P + kr + C_VA + hkv * HD + 2 * lane);
                const float s = wave_sum(q0 * bflo(kw) + q1 * bfhi(kw)) * QK_SCALE;
                const float mn = fmaxf(m, s), al = __expf(m - mn), p = __expf(s - mn);
                lsum = lsum * al + p; o0 = o0 * al + p * bflo(vw); o1 = o1 * al + p * bfhi(vw); m = mn; }
        } else {
            const int b = (row - MP) >> 10, t = (row - MP) & 1023;
            rope_pair(q0, q1, rope + t * 128, lane);
            const int j0 = t - 128 < 0 ? 0 : t - 128, j1 = t + 128 > SEQ_S - 1 ? SEQ_S - 1 : t + 128;
            for (int j = j0; j <= j1; ++j) { const size_t kr = (size_t)(MP + b * SEQ_S + j) * DIN;
                const unsigned kw = *(const GAS unsigned*)(P + kr + C_KA + hkv * HD + 2 * lane), vw = *(const GAS unsigned*)(P + kr + C_VA + hkv * HD + 2 * lane);
                float k0 = bflo(kw), k1 = bfhi(kw); rope_pair(k0, k1, rope + j * 128, lane);
                const float s = wave_sum(q0 * k0 + q1 * k1) * QK_SCALE;
                const float mn = fmaxf(m, s), al = __expf(m - mn), p = __expf(s - mn);
                lsum = lsum * al + p; o0 = o0 * al + p * bflo(vw); o1 = o1 * al + p * bfhi(vw); m = mn; }
            const size_t cbase = (((size_t)b * DEPTH + l) * HKV + hkv) * PAST * HD;
            for (int j = 0; j < PAST; ++j) {
                const unsigned kw = *(const GAS unsigned*)(CK + cbase + (size_t)j * HD + 2 * lane), vw = *(const GAS unsigned*)(CV + cbase + (size_t)j * HD + 2 * lane);
                const float s = wave_sum(q0 * bflo(kw) + q1 * bfhi(kw)) * QK_SCALE;
                const float mn = fmaxf(m, s), al = __expf(m - mn), p = __expf(s - mn);
                lsum = lsum * al + p; o0 = o0 * al + p * bflo(vw); o1 = o1 * al + p * bfhi(vw); m = mn; }
        }
        const float rl = 1.f / lsum;
        *(GAS unsigned*)(MIX + (size_t)row * DM + 1024 + head * HD + 2 * lane) = pk2(o0 * rl, o1 * rl);
    }
}
__device__ __forceinline__ void phase_naive_ret(ArgP a, int l) {
    a = launder(a); const Ids I = make_ids(); const int lane = I.lane, gw = I.gw, NGW = I.NGW;
    const bf16* P = (const bf16*)(a->ws + WS_PROJ); bf16* MIX = (bf16*)(a->ws + WS_MIX);
    for (int it = gw; it < MTOK * NHEAD; it += NGW) {
        const int row = it >> 3, h = it & 7;
        const float lgf = a->in[11][(l * 2 + 0) * NHEAD + h], lgb = a->in[11][(l * 2 + 1) * NHEAD + h];
        const unsigned qw = *(const GAS unsigned*)(P + (size_t)row * DIN + C_QR + h * HD + 2 * lane);
        const float q0 = bflo(qw), q1 = bfhi(qw);
        int base, T, t;
        if (row < MP) { base = row & ~255; T = SEQ_P; t = row & 255; } else { base = MP + ((row - MP) & ~1023); T = SEQ_S; t = (row - MP) & 1023; }
        float o0 = 0.f, o1 = 0.f;
        for (int s = 0; s < T; ++s) { const size_t kr = (size_t)(base + s) * DIN;
            const unsigned kw = *(const GAS unsigned*)(P + kr + C_KR + h * HD + 2 * lane), vw = *(const GAS unsigned*)(P + kr + C_VR + h * HD + 2 * lane);
            const float d = wave_sum(q0 * bflo(kw) + q1 * bfhi(kw)) * QK_SCALE;
            const float w = d * (s < t ? __expf(lgf * (float)(t - s)) : (s > t ? __expf(lgb * (float)(s - t)) : 2.f));
            o0 += w * bflo(vw); o1 += w * bfhi(vw); }
        if (row >= MP) {
            const int b = (row - MP) >> 10;
            const float* s0f = a->in[4] + ((((size_t)b * DEPTH + l) * 2 + 0) * NHEAD + h) * HD * HD; const float* s0b = a->in[4] + ((((size_t)b * DEPTH + l) * 2 + 1) * NHEAD + h) * HD * HD;
            float f0 = 0.f, f1 = 0.f, b0 = 0.f, b1 = 0.f;
            for (int d = 0; d < HD; ++d) { const float qa = __shfl(q0, d >> 1), qb = __shfl(q1, d >> 1), qd = (d & 1) ? qb : qa;
                const float2 sf = *(const float2*)(s0f + d * HD + 2 * lane), sb = *(const float2*)(s0b + d * HD + 2 * lane);
                f0 += qd * sf.x; f1 += qd * sf.y; b0 += qd * sb.x; b1 += qd * sb.y; }
            const float cf = __expf(lgf * (float)(t + 1)), cb = __expf(lgb * (float)(T - t));
            o0 += cf * f0 + cb * b0; o1 += cf * f1 + cb * b1;
        }
        const float mu = wave_sum(o0 + o1) * (1.f / HD); const float d0 = o0 - mu, d1 = o1 - mu;
        const float var = wave_sum(d0 * d0 + d1 * d1) * (1.f / HD), rs = 1.f / sqrtf(var + EPS);
        const float* gn = a->in[12] + l * 1024 + h * HD + 2 * lane;
        const unsigned gw_ = *(const GAS unsigned*)(P + (size_t)row * DIN + C_GR + h * HD + 2 * lane);
        const float y0 = silu_f(bflo(gw_)) * (d0 * rs * gn[0]), y1 = silu_f(bfhi(gw_)) * (d1 * rs * gn[1]);
        *(GAS unsigned*)(MIX + (size_t)row * DM + h * HD + 2 * lane) = pk2(y0, y1);
    }
}
__device__ __forceinline__ void phase_naive_states(ArgP a, int l) {
    a = launder(a); const Ids I = make_ids(); const int gt = I.gt, NGT = I.NGT;
    const bf16* P = (const bf16*)(a->ws + WS_PROJ);
    for (int idx = gt; idx < NB_P * 65536; idx += NGT) {
        const int e4 = idx & 31, d = (idx >> 5) & 127, dir = (idx >> 12) & 1, h = (idx >> 13) & 7, b = idx >> 16;
        const float lg = a->in[11][(l * 2 + dir) * NHEAD + h];
        f32x4 acc = {0.f, 0.f, 0.f, 0.f};
        for (int s = 0; s < SEQ_P; ++s) { const size_t kr = (size_t)(b * SEQ_P + s) * DIN;
            const float kd = bf2f(P[kr + C_KR + h * HD + d]) * QK_SCALE * __expf(lg * (float)(dir == 0 ? SEQ_P - 1 - s : s));
            const v2u vw = *(const GAS v2u*)(P + kr + C_VR + h * HD + e4 * 4);
            acc += kd * (f32x4){bflo(vw.x), bfhi(vw.x), bflo(vw.y), bfhi(vw.y)}; }
        *(GAS f32x4*)(a->out + OUT_ST + (((((size_t)b * DEPTH + l) * 2 + dir) * NHEAD + h) * HD + d) * HD + e4 * 4) = acc;
    }
}

constexpr int NPH_L = 9, PH_FINAL = 2 + DEPTH * NPH_L, NPHASES = PH_FINAL + 1;
__global__ void __launch_bounds__(NWAVES * 64, 2) fwd(Args args) {
    extern __shared__ __attribute__((aligned(16))) unsigned char lds_raw[];
    LAS unsigned char* lds = (LAS unsigned char*)lds_raw;
    ArgP argp = (ArgP)__builtin_amdgcn_kernarg_segment_ptr();
    volatile LAS unsigned* MISC = (volatile LAS unsigned*)(lds + MISC_OFF);
    for (int u = threadIdx.x; u < (LDS_BYTES - 131072) / 4; u += NWAVES * 64) ((LAS unsigned*)(lds + 131072))[u] = 0u;
    __syncthreads();
    const int lo = argp->ph_lo, hi = argp->ph_hi;
    XcdBarrier bar; bar.bar = (unsigned*)(argp->ws + WS_CTL) + CW_BAR; bar.x = 0; bar.st = nullptr;
    if (hi - lo > 1) bar = xcd_barrier_post((unsigned*)(argp->ws + WS_CTL) + CW_BAR, MISC + 8);
#ifndef PHMASK
#define PHMASK 0xFFFFFFFFu
#endif
#define PHON(b) ((PHMASK >> (b)) & 1u)
#define IN(k) (lo <= (k) && (k) < hi)
#define SEAM(k) do { if (IN(k) && IN((k) + 1)) xcd_barrier(bar); } while (0)
#define GEMM_SETUP() ArgP ap = launder(argp); unsigned char* ws = ap->ws; int bx = blockIdx.x, G = gridDim.x; asm volatile("" : "+s"(bx), "+s"(G))
    if (PHON(0) && IN(0)) { phase_prologue_a(argp, lds); SEAM(0); }
    if (PHON(1) && IN(1)) { phase_prologue_b(argp); SEAM(1); }
    for (int l = 0; l < DEPTH; ++l) {
        const int pb = 2 + l * NPH_L;
        if (PHON(2) && IN(pb + 0)) { phase_modulate(argp, l, 0); SEAM(pb + 0); }
        if (PHON(3) && IN(pb + 1)) {
            GEMM_SETUP();
            pg8::Gemm g{(const pg8::bf16_t*)(ws + WS_H), (const pg8::bf16_t*)(ws + WS_WIN) + (size_t)l * DIN * DM, MTOK, DIN, DM}; pg8::StaticOrder S; S.init(MTOK, DIN, G, bx);
            pg8::EpiIn E{(pg8::bf16_t*)(ws + WS_PROJ), ap->out + OUT_CK, ap->out + OUT_CV, l};
            pg8::gemm_phase<pg8::EpiIn, pg8::StaticOrder, true, true>(lds, g, S, E);
            SEAM(pb + 1);
        }
        if (PHON(4) && IN(pb + 2)) { phase_naive_attn(argp, l); phase_naive_states(argp, l); SEAM(pb + 2); }
        if (PHON(5) && IN(pb + 3)) { phase_naive_ret(argp, l); SEAM(pb + 3); }
        if (PHON(6) && IN(pb + 4)) {
            GEMM_SETUP();
            pg8::Gemm g{(const pg8::bf16_t*)(ws + WS_MIX), (const pg8::bf16_t*)(ws + WS_WOUT) + (size_t)l * DM * DM, MTOK, DM, DM}; pg8::StaticOrder S; S.init(MTOK, DM, G, bx);
            pg8::EpiRes E{(float*)(ws + WS_X), (const float*)(ws + WS_MOD) + (size_t)l * NCOND * NMODC + 2 * DM};
            pg8::gemm_phase<pg8::EpiRes, pg8::StaticOrder, true, true>(lds, g, S, E);
            SEAM(pb + 4);
        }
        if (PHON(7) && IN(pb + 5)) { phase_modulate(argp, l, 1); SEAM(pb + 5); }
        if (PHON(8) && IN(pb + 6)) {
            GEMM_SETUP();
            pg8::Gemm g{(const pg8::bf16_t*)(ws + WS_H), (const pg8::bf16_t*)(ws + WS_WUP) + (size_t)l * DUP * DM, MTOK, DUP, DM}; pg8::StaticOrder S; S.init(MTOK, DUP, G, bx);
            pg8::EpiPlain E{(pg8::bf16_t*)(ws + WS_PROJ), DUP};
            pg8::gemm_phase<pg8::EpiPlain, pg8::StaticOrder, true, true>(lds, g, S, E);
            SEAM(pb + 6);
        }
        if (PHON(9) && IN(pb + 7)) { phase_convgate(argp, l); SEAM(pb + 7); }
        if (PHON(10) && IN(pb + 8)) {
            GEMM_SETUP();
            pg8::Gemm g{(const pg8::bf16_t*)(ws + WS_ACT), (const pg8::bf16_t*)(ws + WS_WDN) + (size_t)l * DM * DFF, MTOK, DM, DFF}; pg8::StaticOrder S; S.init(MTOK, DM, G, bx);
            pg8::EpiRes E{(float*)(ws + WS_X), (const float*)(ws + WS_MOD) + (size_t)l * NCOND * NMODC + 5 * DM};
            pg8::gemm_phase<pg8::EpiRes, pg8::StaticOrder, true, true>(lds, g, S, E);
            SEAM(pb + 8);
        }
    }
    if (PHON(11) && IN(PH_FINAL)) phase_final(argp);
#undef IN
#undef SEAM
}

#ifndef N_LAUNCH_MODE
#define N_LAUNCH_MODE 0
#endif
extern "C" void kernel_launch(void* const* d_in, const int* in_sizes, int n_in, void* d_out, int out_size, void* d_ws, size_t ws_size, hipStream_t stream) {
    static int grid = 0;
    if (grid == 0) {
        if (n_in != 19 || (size_t)out_size != OUT_TOTAL || ws_size < WS_END) { fprintf(stderr, "kernel_launch: shape mismatch: n_in %d out %d ws %zu (need %zu)\n", n_in, out_size, ws_size, (size_t)WS_END); grid = -1; return; }
        int dev = 0, cus = 0, per_cu = 0;
        if (hipGetDevice(&dev) != hipSuccess || hipDeviceGetAttribute(&cus, hipDeviceAttributeMultiprocessorCount, dev) != hipSuccess) { grid = -1; return; }
        if (hipFuncSetAttribute((const void*)fwd, hipFuncAttributeMaxDynamicSharedMemorySize, LDS_BYTES) != hipSuccess) { fprintf(stderr, "kernel_launch: hipFuncSetAttribute failed\n"); grid = -1; return; }
        if (hipOccupancyMaxActiveBlocksPerMultiprocessor(&per_cu, (const void*)fwd, NWAVES * 64, LDS_BYTES) != hipSuccess || per_cu < 1) fprintf(stderr, "kernel_launch: occupancy query says %d\n", per_cu);
        (void)hipGetLastError();
        grid = cus;
    }
    if (grid < 0) return;
    if (hipMemsetAsync((char*)d_ws + WS_CTL, 0, CTL_ZERO_BYTES, stream) != hipSuccess) return;
    Args a{};
    for (int i = 0; i < 19; ++i) a.in[i] = (const float*)d_in[i];
    a.out = (float*)d_out; a.ws = (unsigned char*)d_ws;
    if (N_LAUNCH_MODE == 1) { a.ph_lo = 0; a.ph_hi = NPHASES; hipLaunchKernelGGL(fwd, dim3(grid), dim3(NWAVES * 64), LDS_BYTES, stream, a); }
    else for (int p = 0; p < NPHASES; ++p) { a.ph_lo = p; a.ph_hi = p + 1; hipLaunchKernelGGL(fwd, dim3(grid), dim3(NWAVES * 64), LDS_BYTES, stream, a); }
    const hipError_t le = hipPeekAtLastError();
    if (le != hipSuccess) fprintf(stderr, "kernel_launch: launch failed: %s\n", hipGetErrorName(le));
}
```

```cpp
#include <hip/hip_runtime.h>
#include <cstdio>
#include <cstdint>
#define WMAP_OFF 131584
__device__ __forceinline__ int tid_now() {
    const unsigned slot = (unsigned)__builtin_amdgcn_s_getreg((5 << 11) | 4) & 63u;
    const int w = __builtin_amdgcn_readfirstlane(*(const __attribute__((address_space(3))) int*)(unsigned long)(WMAP_OFF + 4 * slot));
    int ln; asm volatile("v_mbcnt_lo_u32_b32 %0, -1, 0\n\tv_mbcnt_hi_u32_b32 %0, -1, %0" : "=v"(ln));
    return w * 64 + ln;
}
__device__ __forceinline__ void tid_publish(int tid) {
    const unsigned slot = (unsigned)__builtin_amdgcn_s_getreg((5 << 11) | 4) & 63u;
    if ((tid & 63) == 0) *(__attribute__((address_space(3))) int*)(unsigned long)(WMAP_OFF + 4 * slot) = tid >> 6;
}
namespace pg8 {
#define PG8_LAS __attribute__((address_space(3)))
typedef unsigned short bf16_t;
typedef short bf16x8 __attribute__((ext_vector_type(8)));
typedef float f32x4 __attribute__((ext_vector_type(4)));
typedef unsigned u32x4 __attribute__((ext_vector_type(4)));
constexpr int BM = 256, BK = 64, HALF = 128, HTB = HALF * BK * 2  , STAGE_BYTES = 8 * HTB, NXCD = 8, WGM = 8;

__host__ __device__ __forceinline__ int lds_byte(int r, int c) { const int st = (r >> 4) * 2 + (c >> 5), rr = r & 15, cc = c & 31, ob = rr * 64 + cc * 2; return st * 1024 + (ob ^ (((ob >> 9) & 1) << 5)); }
__host__ __device__ __forceinline__ void stage_rc(int b, int& R, int& C) { const int st = b / 1024, sb = b % 1024, swz = sb ^ (((sb >> 9) & 1) << 5); R = (st >> 1) * 16 + swz / 64; C = (st & 1) * 32 + (swz % 64) / 2; }
__host__ __device__ __forceinline__ int perm32(int rho) { const int n = rho >> 4, i = rho & 15; return 8 * (i >> 2) + 4 * n + (i & 3); }

struct Unit { int pm, pn, half, h, part, slab; };
struct Gemm { const bf16_t* A; const bf16_t* Bt; int M, N, K; };

struct StaticOrder {
    static constexpr bool KSPLIT = false, DYN = false;
    int nM, nN, nwg, G, c;
    __host__ __device__ void init(int M, int N, int G_, int c_) { nM = M / BM; nN = N / BM; nwg = nM * nN; G = G_; c = c_; }
    __host__ __device__ bool next(int i, Unit& u) const { const long L = (long)i * G + c; if (L >= nwg) return false; tile((int)L, u); return true; }
    __host__ __device__ bool tile(int L, Unit& u) const {
        int wgid = L; { const int q = nwg / NXCD, r = nwg % NXCD, xcd = wgid % NXCD, off = wgid / NXCD; wgid = (xcd < r ? xcd * (q + 1) : r * (q + 1) + (xcd - r) * q) + off; }
        const int nig = WGM * nN, gid = wgid / nig, fm = gid * WGM, gsz = (nM - fm) < WGM ? (nM - fm) : WGM;
        u.pm = fm + ((wgid % nig) % gsz); u.pn = (wgid % nig) / gsz; u.half = 0; u.h = 0; u.part = 0; u.slab = 0; return true;
    }
    __device__ __forceinline__ void a_ready(const Unit&) const {}
    __device__ __forceinline__ void done(const Unit&) const {}
};
struct TailOrder : StaticOrder {
    int nfull;
    __device__ __forceinline__ void init2(int M, int N, int G_, int c_, int nfull_) { init(M, N, G_, c_); nfull = nfull_; }
    __device__ __forceinline__ bool next(int i, Unit& u) const {
        if (G != 256) return StaticOrder::next(i, u);
        const int nr = nfull >> 8;
        if (i < nr) { tile(i * 256 + c, u); return true; }
        const int x = c & 7, q = c >> 3, j = (q >> 1) * 8 + x;
        if (i > nr || nfull + j >= nwg) return false;
        tile(nfull + j, u); u.half = 1; u.h = q & 1; return true;
    }
};
struct TailOrderK : StaticOrder {
    static constexpr bool KSPLIT = true;
    int nfull; float* slab; unsigned* flags; unsigned epoch;
    __device__ __forceinline__ void init2(int M, int N, int G_, int c_, int nfull_, float* slab_, unsigned* flags_, unsigned epoch_) { init(M, N, G_, c_); nfull = nfull_; slab = slab_; flags = flags_; epoch = epoch_; }
    __device__ __forceinline__ bool next(int i, Unit& u) const {
        if (G != 256) return StaticOrder::next(i, u);
        const int nr = nfull >> 8;
        if (i < nr) { tile(i * 256 + c, u); return true; }
        const int x = c & 7, q = c >> 3, j = (q >> 1) * 8 + x;
        if (i > nr || nfull + j >= nwg) return false;
        tile(nfull + j, u); u.part = 1 + (q & 1); u.slab = j; return true;
    }
};
struct InMainOrder {
    static constexpr bool KSPLIT = false, DYN = false;
    int G, c;
    __device__ __forceinline__ void init(int G_, int c_) { G = G_; c = c_; }
    __device__ __forceinline__ bool next(int i, Unit& u) const {
        const int L = i * G + c; if (L >= 1024) return false;
        const int w = (G == 256) ? (c & 7) * 128 + i * 32 + (c >> 3) : L;
        if (w < 880) { const int r = w % 176; u.pm = (w / 176) * 8 + (r & 7); u.pn = r >> 3; } else { const int r = w - 880; u.pm = 40 + (r & 7); u.pn = 4 + (r >> 3); }
        u.half = 0; u.h = 0; u.part = 0; u.slab = 0; return true;
    }
    __device__ __forceinline__ void a_ready(const Unit&) const {}
    __device__ __forceinline__ void done(const Unit&) const {}
};
struct TailOrderDyn : StaticOrder {
    static constexpr bool DYN = true;
    int nfull; unsigned* ctr; PG8_LAS unsigned* slot;
    __device__ __forceinline__ void init2(int M, int N, int G_, int c_, int nfull_, unsigned* ctr_, PG8_LAS unsigned* slot_) { init(M, N, G_, c_); nfull = nfull_; ctr = ctr_; slot = slot_; }
    __device__ __forceinline__ void pre_epi(int ui, int tid) const {
        if (G != 256 || ui != (nfull >> 8) - 2) return;
        if (tid == 0) { const unsigned t = __hip_atomic_fetch_add(ctr, 1u, __ATOMIC_RELAXED, __HIP_MEMORY_SCOPE_AGENT); *slot = t; asm volatile("s_waitcnt lgkmcnt(0)" ::: "memory"); }
    }
    __device__ __forceinline__ bool next(int i, Unit& u) const {
        if (G != 256) return StaticOrder::next(i, u);
        const int nr = nfull >> 8;
        if (i < nr) { tile(i * 256 + c, u); return true; }
        if (i > nr) return false;
        const int t = __builtin_amdgcn_readfirstlane((int)*slot);
        if (nfull + t >= nwg) return false;
        tile(nfull + t, u); return true;
    }
};
struct OneUnit {
    static constexpr bool KSPLIT = false, DYN = false;
    Unit u;
    __device__ __forceinline__ bool next(int i, Unit& o) const { if (i != 0) return false; o = u; return true; }
    __device__ __forceinline__ void a_ready(const Unit&) const {}
    __device__ __forceinline__ void done(const Unit&) const {}
};
__device__ __forceinline__ unsigned cvt_pk_bf16(float lo, float hi) { unsigned r; asm volatile("v_cvt_pk_bf16_f32 %0, %1, %2" : "=v"(r) : "v"(lo), "v"(hi)); return r; }
template <class Epi, class Sched, bool ALIGN_EPI = false, bool SP2 = false>
__device__ __forceinline__ void gemm_phase(PG8_LAS unsigned char* lds, const Gemm g, const Sched& S, const Epi& E) {
    int tid_ = tid_now(); asm volatile("" : "+v"(tid_));
    const int tid = tid_, wid = __builtin_amdgcn_readfirstlane(tid >> 6), lane = tid & 63, wr = wid >> 2, wc = wid & 3, fr = lane & 15, fq = lane >> 4;
    const int K = g.K, nt = K / BK;
    unsigned voffA[2], voffB[2];
#pragma unroll
    for (int i = 0; i < 2; ++i) { int R, C; stage_rc(tid * 16 + i * 8192, R, C); const int Rb = Epi::PERM ? ((R & ~31) + perm32(R & 31)) : R;
        voffA[i] = (unsigned)(R * K + C) * 2u; voffB[i] = (unsigned)(Rb * K + C) * 2u; }
    const size_t kstep = (size_t)(BK * 2);
    const size_t hstep = (size_t)HALF * K * 2;
    const size_t tstep = 2 * hstep;
    const unsigned ldsw = (unsigned)wid * 1024u;
    const int aoff = lds_byte(wr * 64 + fr, fq * 8), boff = lds_byte(wc * 32 + fr, fq * 8);
#define PG8_SA(b, h) (((b) * 2 + (h)) * HTB)
#define PG8_SB(b, h) ((4 + (b) * 2 + (h)) * HTB)
#define PG8_STAGE(bufoff, gbase, voff) do { _Pragma("unroll") for (int _i = 0; _i < 2; ++_i) \
        __builtin_amdgcn_global_load_lds((const unsigned*)((const char*)(gbase) + (voff)[_i]), (PG8_LAS unsigned*)(lds + (bufoff) + ldsw + _i * 8192), 16, 0, 0); } while (0)
#define PG8_LDA(dst, b, h) do { _Pragma("unroll") for (int m = 0; m < 4; ++m) _Pragma("unroll") for (int k = 0; k < 2; ++k) dst[m][k] = *(const PG8_LAS bf16x8*)(lds + PG8_SA(b, h) + aoff + m * 2048 + k * 1024); } while (0)
#define PG8_LDB(dst, b, h) do { _Pragma("unroll") for (int n = 0; n < 2; ++n) _Pragma("unroll") for (int k = 0; k < 2; ++k) dst[n][k] = *(const PG8_LAS bf16x8*)(lds + PG8_SB(b, h) + boff + n * 2048 + k * 1024); } while (0)
#define PG8_MMA(ai, bj, At, Bt) do { __builtin_amdgcn_s_setprio(1); _Pragma("unroll") for (int m = 0; m < 4; ++m) _Pragma("unroll") for (int n = 0; n < 2; ++n) _Pragma("unroll") for (int k = 0; k < 2; ++k) \
        acc[ai][bj][m][n] = __builtin_amdgcn_mfma_f32_16x16x32_bf16(Bt[n][k], At[m][k], acc[ai][bj][m][n], 0, 0, 0); __builtin_amdgcn_s_setprio(0); } while (0)
#define PG8_WAIT_V(n) asm volatile("s_waitcnt vmcnt(" #n ")" ::: "memory")
#define PG8_WAIT_L(n) asm volatile("s_waitcnt lgkmcnt(" #n ")" ::: "memory")
#define PG8_BAR __builtin_amdgcn_s_barrier()
#define PG8_SCHED __builtin_amdgcn_sched_barrier(0)
    Unit cur, nxt; int ui = 0;
    if (!S.next(0, cur)) return;
    f32x4 acc[2][2][4][2];
#pragma unroll
    for (int a = 0; a < 2; ++a)
#pragma unroll
        for (int b = 0; b < 2; ++b)
#pragma unroll
            for (int m = 0; m < 4; ++m)
#pragma unroll
                for (int n = 0; n < 2; ++n) acc[a][b][m][n] = (f32x4){0.f, 0.f, 0.f, 0.f};
    bf16x8 At[4][2], B0[2][2], B1[2][2];
    const size_t khalf = (size_t)(nt >> 1) * kstep;
    const char* cA = (const char*)g.A + (size_t)cur.pm * tstep + (size_t)cur.h * hstep + (cur.part == 2 ? khalf : 0); const char* cB = (const char*)g.Bt + (size_t)cur.pn * tstep + (cur.part == 2 ? khalf : 0);
    S.a_ready(cur);
    if constexpr (SP2) {
        PG8_STAGE(PG8_SB(0, 0), cB, voffB); PG8_STAGE(PG8_SB(0, 1), cB + hstep, voffB); PG8_STAGE(PG8_SA(0, 0), cA, voffA); PG8_STAGE(PG8_SA(0, 1), cA + hstep, voffA);
        if (wr == 1) PG8_BAR;
        PG8_WAIT_V(2); PG8_BAR;
        PG8_STAGE(PG8_SB(1, 0), cB + kstep, voffB); PG8_STAGE(PG8_SA(1, 0), cA + kstep, voffA); PG8_STAGE(PG8_SB(1, 1), cB + hstep + kstep, voffB);
        PG8_WAIT_V(6); PG8_BAR;
    } else {
        PG8_STAGE(PG8_SB(0, 0), cB, voffB); PG8_STAGE(PG8_SA(0, 0), cA, voffA); PG8_STAGE(PG8_SB(0, 1), cB + hstep, voffB); PG8_STAGE(PG8_SA(0, 1), cA + hstep, voffA);
        if (wr == 1) PG8_BAR;
        PG8_WAIT_V(4); PG8_BAR;
        PG8_STAGE(PG8_SB(1, 0), cB + kstep, voffB); PG8_STAGE(PG8_SA(1, 0), cA + kstep, voffA); PG8_STAGE(PG8_SB(1, 1), cB + hstep + kstep, voffB);
        PG8_WAIT_V(6); PG8_BAR;
    }
    for (;;) {
        const bool has_next = S.next(ui + 1, nxt);
        const char* nA = has_next ? (const char*)g.A + (size_t)nxt.pm * tstep + (size_t)nxt.h * hstep + (nxt.part == 2 ? khalf : 0) : cA; const char* nB = has_next ? (const char*)g.Bt + (size_t)nxt.pn * tstep + (nxt.part == 2 ? khalf : 0) : cB;
        const int ntc = cur.part ? (nt >> 1) : nt;
        for (int t = 0; t < ntc; t += 2) {
            const bool last = (t == ntc - 2);
            const char* a1 = cA + (size_t)(t + 1) * kstep;
            const char* a2 = last ? nA : cA + (size_t)(t + 2) * kstep; const char* b2 = last ? nB : cB + (size_t)(t + 2) * kstep;
            const char* a3 = a2 + kstep; const char* b3 = b2 + kstep;
            if (last && has_next) S.a_ready(nxt);
            if constexpr (SP2) {
            PG8_LDB(B0, 0, 0); PG8_LDB(B1, 0, 1); PG8_SCHED; PG8_LDA(At, 0, 0); PG8_STAGE(PG8_SA(1, 1), a1 + hstep, voffA);
            PG8_WAIT_V(8); PG8_WAIT_L(0); PG8_BAR; PG8_MMA(0, 0, At, B0); PG8_MMA(0, 1, At, B1); PG8_BAR; PG8_SCHED;
            PG8_LDA(At, 0, 1); PG8_STAGE(PG8_SB(0, 0), b2, voffB); PG8_STAGE(PG8_SB(0, 1), b2 + hstep, voffB); PG8_STAGE(PG8_SA(0, 0), a2, voffA);
            PG8_WAIT_V(8); PG8_WAIT_L(0); PG8_BAR; if (!cur.half) { PG8_MMA(1, 0, At, B0); PG8_MMA(1, 1, At, B1); } PG8_BAR; PG8_SCHED;
            PG8_LDB(B0, 1, 0); PG8_LDB(B1, 1, 1); PG8_SCHED; PG8_LDA(At, 1, 0); PG8_STAGE(PG8_SA(0, 1), a2 + hstep, voffA);
            PG8_WAIT_V(8); PG8_WAIT_L(0); PG8_BAR; PG8_MMA(0, 0, At, B0); PG8_MMA(0, 1, At, B1); PG8_BAR; PG8_SCHED;
            PG8_LDA(At, 1, 1); PG8_STAGE(PG8_SB(1, 0), b3, voffB); PG8_STAGE(PG8_SB(1, 1), b3 + hstep, voffB); PG8_STAGE(PG8_SA(1, 0), a3, voffA);
            PG8_WAIT_V(8); PG8_WAIT_L(0); PG8_BAR; if (!cur.half) { PG8_MMA(1, 0, At, B0); PG8_MMA(1, 1, At, B1); } PG8_BAR; PG8_SCHED;
            } else {
            PG8_LDB(B0, 0, 0); PG8_SCHED; PG8_LDA(At, 0, 0); PG8_STAGE(PG8_SA(1, 1), a1 + hstep, voffA);
            PG8_WAIT_L(8); PG8_BAR; PG8_WAIT_L(0); PG8_MMA(0, 0, At, B0); PG8_BAR; PG8_SCHED;
            PG8_LDB(B1, 0, 1); PG8_STAGE(PG8_SB(0, 0), b2, voffB);
            PG8_BAR; PG8_WAIT_L(0); PG8_MMA(0, 1, At, B1); PG8_BAR;
            PG8_LDA(At, 0, 1); PG8_STAGE(PG8_SA(0, 0), a2, voffA);
            PG8_BAR; PG8_WAIT_L(0); PG8_MMA(1, 0, At, B0); PG8_BAR; PG8_SCHED;
            PG8_STAGE(PG8_SB(0, 1), b2 + hstep, voffB);
            PG8_WAIT_V(6); PG8_BAR; PG8_MMA(1, 1, At, B1); PG8_BAR;
            PG8_LDB(B0, 1, 0); PG8_SCHED; PG8_LDA(At, 1, 0); PG8_STAGE(PG8_SA(0, 1), a2 + hstep, voffA);
            PG8_WAIT_L(8); PG8_BAR; PG8_WAIT_L(0); PG8_MMA(0, 0, At, B0); PG8_BAR; PG8_SCHED;
            PG8_LDB(B1, 1, 1); PG8_STAGE(PG8_SB(1, 0), b3, voffB);
            PG8_BAR; PG8_WAIT_L(0); PG8_MMA(0, 1, At, B1); PG8_BAR;
            PG8_LDA(At, 1, 1); PG8_STAGE(PG8_SA(1, 0), a3, voffA);
            PG8_BAR; PG8_WAIT_L(0); PG8_MMA(1, 0, At, B0); PG8_BAR; PG8_SCHED;
            PG8_STAGE(PG8_SB(1, 1), b3 + hstep, voffB);
            PG8_WAIT_V(6); PG8_BAR; PG8_MMA(1, 1, At, B1); PG8_BAR;
            }
        }
        if constexpr (ALIGN_EPI) { if (wr == 0) PG8_BAR; }
        if constexpr (Sched::KSPLIT) {
            if (cur.part != 0) {
                const int own = cur.part - 1;
                const char* slb = (const char*)(S.slab + (size_t)cur.slab * 65536 + (size_t)(1 - own) * 32768); unsigned* flg = S.flags + 64 * (2 * cur.slab);
                const unsigned voff = (unsigned)tid * 16u;
                if (own == 0) {
#pragma unroll
                    for (int b = 0; b < 2; ++b)
#pragma unroll
                        for (int m = 0; m < 4; ++m)
#pragma unroll
                            for (int n = 0; n < 2; ++n) { const char* bi = slb + (size_t)(((b * 4 + m) * 2 + n) * 8192); asm volatile("global_store_dwordx4 %0, %1, %2 sc1" :: "v"(voff), "v"(acc[1][b][m][n]), "s"(bi) : "memory"); }
                } else {
#pragma unroll
                    for (int b = 0; b < 2; ++b)
#pragma unroll
                        for (int m = 0; m < 4; ++m)
#pragma unroll
                            for (int n = 0; n < 2; ++n) { const char* bi = slb + (size_t)(((b * 4 + m) * 2 + n) * 8192); asm volatile("global_store_dwordx4 %0, %1, %2 sc1" :: "v"(voff), "v"(acc[0][b][m][n]), "s"(bi) : "memory"); }
                }
                PG8_WAIT_V(0); PG8_BAR;
                if (tid == 0) __hip_atomic_store(flg + 64 * (1 - own), S.epoch, __ATOMIC_RELAXED, __HIP_MEMORY_SCOPE_AGENT);
                if (wid == 0) { unsigned sp = 0; while ((unsigned)__builtin_amdgcn_readfirstlane(__hip_atomic_load(flg + 64 * own, __ATOMIC_RELAXED, __HIP_MEMORY_SCOPE_AGENT)) != S.epoch) { __builtin_amdgcn_s_sleep(2); if (++sp > (1u << 18)) break; }
                    __builtin_amdgcn_fence(__ATOMIC_ACQUIRE, "agent"); PG8_WAIT_V(0); }
                PG8_BAR; asm volatile("" ::: "memory");
                cur.half = 1; cur.h = own;
            }
        }
        if constexpr (Sched::DYN) S.pre_epi(ui, tid);
        constexpr bool run_epi = true;
        if constexpr (!Epi::AFTER_DRAIN) { if (run_epi) { E(acc, cur, wr, wc, fr, fq); S.done(cur); } }
        if (!has_next) break;
#pragma unroll
        for (int a = 0; a < 2; ++a)
#pragma unroll
            for (int b = 0; b < 2; ++b)
#pragma unroll
                for (int m = 0; m < 4; ++m)
#pragma unroll
                    for (int n = 0; n < 2; ++n) acc[a][b][m][n] = (f32x4){0.f, 0.f, 0.f, 0.f};
        cur = nxt; cA = nA; cB = nB; ++ui;
        if constexpr (ALIGN_EPI) { if (wr == 1) PG8_BAR; }
    }
    PG8_WAIT_V(0);
    if constexpr (!ALIGN_EPI) { if (wr == 0) PG8_BAR; }
    PG8_BAR;
    if constexpr (Epi::AFTER_DRAIN) { E.fused(acc, cur, wr, wc, fr, fq, lds, wid, lane); S.done(cur); }
#undef PG8_SA
#undef PG8_SB
#undef PG8_STAGE
#undef PG8_LDA
#undef PG8_LDB
#undef PG8_MMA
#undef PG8_WAIT_V
#undef PG8_WAIT_L
#undef PG8_BAR
#undef PG8_SCHED
}
}

#define GAS __attribute__((address_space(1)))
#define LAS __attribute__((address_space(3)))
typedef unsigned short bf16;
typedef unsigned v4u __attribute__((ext_vector_type(4)));
typedef float f32x4 __attribute__((ext_vector_type(4)));
typedef short bf16x8 __attribute__((ext_vector_type(8)));
typedef GAS unsigned gu32;
typedef GAS unsigned long long gu64;
#define RLX_AGENT __ATOMIC_RELAXED, __HIP_MEMORY_SCOPE_AGENT
#define LDS_WAIT() asm volatile("s_waitcnt lgkmcnt(0)" ::: "memory")
#define VM_WAIT() asm volatile("s_waitcnt vmcnt(0)" ::: "memory")
__device__ __forceinline__ unsigned long long rt() { return __builtin_amdgcn_s_memrealtime(); }
__device__ __forceinline__ unsigned pk2(float lo, float hi) { unsigned r; asm("v_cvt_pk_bf16_f32 %0, %1, %2" : "=v"(r) : "v"(lo), "v"(hi)); return r; }
__device__ __forceinline__ unsigned f2bf(float f) { return pk2(f, f) & 0xffffu; }
#define XB_TMO      128
#define XB_XCNT(j)  (256  + 64 * (j))
#define XB_XSUB(j)  (1280 + 64 * (j))
#define XB_XGEN(j)  (2304 + 64 * (j))
#define XB_TOP      3328
#define XB_TOPGEN   3392
#define XCD_BAR_WORDS 3456
#define XB_SPIN_CAP (1u << 18)

__device__ __forceinline__ unsigned xb_ld(unsigned* p)              { return __hip_atomic_load(p, __ATOMIC_RELAXED, __HIP_MEMORY_SCOPE_AGENT); }
__device__ __forceinline__ unsigned xb_add(unsigned* p, unsigned v) { return __hip_atomic_fetch_add(p, v, __ATOMIC_RELAXED, __HIP_MEMORY_SCOPE_AGENT); }
__device__ __forceinline__ unsigned xb_xcc_id() { return (unsigned)__builtin_amdgcn_s_getreg((3 << 11) | 20) & 0xFu; }
#define XB_SPIN(cond, bar) do { unsigned _sp = 0; while (cond) { __builtin_amdgcn_s_sleep(1); \
    if ((++_sp & 255u) == 0u) { if (xb_ld(&(bar)[XB_TMO])) break; if (_sp > XB_SPIN_CAP) { atomicAdd(&(bar)[XB_TMO], 1u); break; } } } } while (0)

struct XcdBarrier {
    unsigned* bar; unsigned x;
    volatile LAS unsigned* st;
};

__device__ __forceinline__ XcdBarrier xcd_barrier_post(unsigned* bar, volatile LAS unsigned* st) {
    XcdBarrier b; b.bar = bar; b.x = xb_xcc_id(); b.st = st;
    if (tid_now() == 0) (void)xb_add(&bar[XB_XCNT(b.x)], 1u);
    return b;
}
__device__ __forceinline__ void xcd_barrier_complete(unsigned* bar, unsigned x, unsigned& nloc, unsigned& nx) {
    const unsigned G = gridDim.x * gridDim.y * gridDim.z;
    unsigned sum, cnt, mine, sp = 0u;
    for (;;) {
        sum = 0u; cnt = 0u; mine = 0u;
#pragma unroll
        for (unsigned j = 0; j < 16; ++j) { const unsigned c = xb_ld(&bar[XB_XCNT(j)]); sum += c; cnt += (c > 0u) ? 1u : 0u; mine = (j == x) ? c : mine; }
        if (sum == G) break;
        __builtin_amdgcn_s_sleep(1);
        if ((++sp & 255u) == 0u) { if (xb_ld(&bar[XB_TMO])) break; if (sp > XB_SPIN_CAP) { atomicAdd(&bar[XB_TMO], 1u); break; } }
    }
    nloc = mine > 0u ? mine : 1u; nx = cnt > 0u ? cnt : 1u;
}

__device__ __forceinline__ void xcd_barrier(const XcdBarrier& b) {
    asm volatile("s_waitcnt vmcnt(0)" ::: "memory");
    __syncthreads();
    if (tid_now() == 0) {
        unsigned* bar = b.bar;
        __builtin_amdgcn_s_waitcnt(0);
        unsigned nloc = b.st[0], nx = b.st[1];
        if (nloc == 0u) { xcd_barrier_complete(bar, b.x, nloc, nx); b.st[0] = nloc; b.st[1] = nx; }
        const unsigned old = xb_add(&bar[XB_XSUB(b.x)], 1u);
        const unsigned gen = old / nloc;
        if (old + 1u == (gen + 1u) * nloc) {
            __builtin_amdgcn_fence(__ATOMIC_RELEASE, "agent");
            asm volatile("s_waitcnt vmcnt(0)" ::: "memory");
            const unsigned og = xb_add(&bar[XB_TOP], 1u);
            const unsigned tg = og / nx;
            if (og + 1u == (tg + 1u) * nx) xb_add(&bar[XB_TOPGEN], 1u);
            else XB_SPIN(xb_ld(&bar[XB_TOPGEN]) == tg, bar);
            __builtin_amdgcn_fence(__ATOMIC_ACQUIRE, "agent");
            xb_add(&bar[XB_XGEN(b.x)], 1u);
            asm volatile("s_waitcnt vmcnt(0)" ::: "memory");
        } else {
            XB_SPIN(xb_ld(&bar[XB_XGEN(b.x)]) == gen, bar);
            __builtin_amdgcn_fence(__ATOMIC_ACQUIRE, "agent");
            asm volatile("s_waitcnt vmcnt(0)" ::: "memory");
        }
    }
    __syncthreads();
}

constexpr int DM = 2048, NB_P = 32, SEQ_P = 256, NB_S = 4, SEQ_S = 1024, PAST = 512, DEPTH = 4;
constexpr int MP = NB_P * SEQ_P, MS = NB_S * SEQ_S, MTOK = MP + MS;
constexpr int NHEAD = 8, HKV = 2, HD = 128;
constexpr int DIN = 5632, DFF = 5632, DUP = 2 * DFF, NMODC = 6 * DM;
constexpr int C_QR = 0, C_KR = 1024, C_VR = 2048, C_GR = 3072, C_QA = 4096, C_KA = 5120, C_VA = 5376;
constexpr int NCOND = 5;
constexpr float EPS = 1e-6f, LOG2E = 1.4426950408889634f;
constexpr float QK_SCALE = 0.08838834764831845f;
constexpr size_t OUT_Y = 0, OUT_CK = (size_t)MTOK * DM, OUT_CV = OUT_CK + (size_t)NB_P * DEPTH * HKV * SEQ_P * HD, OUT_ST = OUT_CV + (size_t)NB_P * DEPTH * HKV * SEQ_P * HD;
constexpr size_t OUT_TOTAL = OUT_ST + (size_t)NB_P * DEPTH * 2 * NHEAD * HD * HD;
constexpr size_t MiB = 1u << 20;
constexpr size_t WS_CTL = 0, CTL_ZERO_BYTES = 1 * MiB;
constexpr size_t WS_ROPE = 1 * MiB, WS_MOD = 2 * MiB, WS_MODP = 3 * MiB, WS_CKB = 18 * MiB, WS_CVB = 22 * MiB, WS_SRET = 26 * MiB;
constexpr size_t WS_WIN = 58 * MiB, WS_WOUT = 146 * MiB, WS_WUP = 178 * MiB, WS_WDN = 354 * MiB;
constexpr size_t WS_X = 442 * MiB, WS_H = 538 * MiB, WS_MIX = 586 * MiB, WS_ACT = 634 * MiB, WS_PROJ = 766 * MiB, WS_SLAB = 1032 * MiB, WS_END = 1064 * MiB;
constexpr size_t WS_RSS1 = WS_ROPE + 512 * 1024, WS_RSS2 = WS_RSS1 + 64 * 1024;
constexpr size_t WS_SWIN = 1030 * MiB, WS_SWUP = WS_SWIN + 512 * 1024;
constexpr size_t WS_HALO = WS_MODP + 2 * MiB;
constexpr int EX_OFF = 132096;
constexpr int KCH = 16;
constexpr int CW_BAR = 4096, CW_KS = 32768, CW_TK = 200000; constexpr int TK_SLOT = 131072 + 320 + 160;
constexpr int LDS_BYTES = 147456;
constexpr int MISC_OFF = 131072 + 320;
constexpr int NWAVES = 8;

typedef unsigned v2u __attribute__((ext_vector_type(2)));
struct Args;
typedef const __attribute__((address_space(4))) Args* ArgP;
struct Args { const float* in[19]; float* out; unsigned char* ws; int ph_lo, ph_hi; };

__device__ __forceinline__ float shx(float v, int o, int lane) { return __builtin_bit_cast(float, __builtin_amdgcn_ds_bpermute((lane ^ o) << 2, __builtin_bit_cast(int, v))); }
__device__ __forceinline__ unsigned shxu(unsigned v, int o, int lane) { return (unsigned)__builtin_amdgcn_ds_bpermute((lane ^ o) << 2, (int)v); }
__device__ __forceinline__ float wave_sum(float v, int lane) {
#pragma unroll
    for (int o = 1; o < 64; o <<= 1) v += shx(v, o, lane);
    return v;
}
struct Ids { int tid, lane, wave, bx, G, gw, NGW, gt, NGT; };
__device__ __forceinline__ Ids make_ids() {
    Ids I; int t = tid_now(); asm volatile("" : "+v"(t)); int bx = blockIdx.x, G = gridDim.x; asm volatile("" : "+s"(bx), "+s"(G));
    I.tid = t; I.lane = t & 63; I.wave = __builtin_amdgcn_readfirstlane(t >> 6); I.bx = bx; I.G = G;
    const int vcu = (G % 8 == 0) ? (bx % 8) * (G / 8) + bx / 8 : bx;
    I.gw = vcu * 8 + I.wave; I.NGW = G * 8; I.gt = I.gw * 64 + I.lane; I.NGT = I.NGW * 64; return I;
}
__device__ __forceinline__ ArgP launder(ArgP a) { asm volatile("" : "+s"(a)); return a; }
__device__ __forceinline__ float bf2f(unsigned short b) { return __builtin_bit_cast(float, (unsigned)b << 16); }
__device__ __forceinline__ float bflo(unsigned w) { return __builtin_bit_cast(float, w << 16); }
__device__ __forceinline__ float bfhi(unsigned w) { return __builtin_bit_cast(float, w & 0xffff0000u); }
__device__ __forceinline__ float silu_f(float x) { return x * __builtin_amdgcn_rcpf(1.f + __builtin_amdgcn_exp2f(-LOG2E * x)); }
__device__ __forceinline__ int cond_of_row(int row) { return row < MP ? 0 : 1 + ((row - MP) >> 10); }

__device__ __forceinline__ void transpose_load(const float* W, int N, int item, int lane, f32x4 (&wv)[8]) {
    const int nblk = N / 32, kb = item / nblk, nb = item % nblk, k0 = 64 * kb, n0 = 32 * nb;
#pragma unroll
    for (int i = 0; i < 8; ++i) wv[i] = __builtin_nontemporal_load((const GAS f32x4*)(W + (size_t)(k0 + 8 * i + (lane >> 3)) * N + n0 + 4 * (lane & 7)));
}
typedef float f32x16t __attribute__((ext_vector_type(16)));
template <bool REMAP_UP, bool SW>
__device__ __forceinline__ void transpose_item(const f32x4 (&wv)[8], int K, int N, bf16* WT, LAS float* scr, const LAS unsigned char* tabB, float* sw, int item, int lane) {
    const int nblk = N / 32, kb = item / nblk, nb = item % nblk, k0 = 64 * kb, n0 = 32 * nb;
    const int d0 = REMAP_UP ? (n0 < DFF ? (n0 >> 7) * 256 + (n0 & 127) : ((n0 - DFF) >> 7) * 256 + 128 + ((n0 - DFF) & 127)) : n0;
#pragma unroll
    for (int i = 0; i < 8; ++i) { LAS float* d = scr + (8 * i + (lane >> 3)) * 33 + 4 * (lane & 7); d[0] = wv[i].x; d[1] = wv[i].y; d[2] = wv[i].z; d[3] = wv[i].w; }
    LDS_WAIT(); asm volatile("" ::: "memory");
    if (SW) {
        const int n = lane & 31, hi = lane >> 5; f32x16t acc = (f32x16t){};
#pragma unroll
        for (int ks = 0; ks < 4; ++ks) { const LAS float* s = scr + ((2 * ks + hi) * 8) * 33 + n;
            v4u bw; bw.x = pk2(s[0 * 33], s[1 * 33]); bw.y = pk2(s[2 * 33], s[3 * 33]); bw.z = pk2(s[4 * 33], s[5 * 33]); bw.w = pk2(s[6 * 33], s[7 * 33]);
            const v4u aw = *(const LAS v4u*)(tabB + (((k0 >> 3) + 2 * ks + hi) * 8 + (lane & 7)) * 16);
            acc = __builtin_amdgcn_mfma_f32_32x32x16_bf16(__builtin_bit_cast(bf16x8, aw), __builtin_bit_cast(bf16x8, bw), acc, 0, 0, 0); }
#pragma unroll
        for (int r = 0; r < 4; ++r) { const int j = r + 4 * hi; if (j < NCOND) unsafeAtomicAdd(sw + (size_t)j * N + d0 + n, acc[r]); } }
    const int c = lane & 7;
#pragma unroll
    for (int j = 0; j < 4; ++j) { const int n = (lane >> 3) + 8 * j; const LAS float* s = scr + (8 * c) * 33 + n;
        v4u o; o.x = pk2(s[0 * 33], s[1 * 33]); o.y = pk2(s[2 * 33], s[3 * 33]); o.z = pk2(s[4 * 33], s[5 * 33]); o.w = pk2(s[6 * 33], s[7 * 33]);
        __builtin_nontemporal_store(o, (GAS v4u*)(WT + (size_t)(d0 + n) * K + k0 + 8 * c)); }
    LDS_WAIT(); asm volatile("" ::: "memory");
}
template <bool REMAP_UP, bool SW>
__device__ __forceinline__ void transpose_range(const float* W, int K, int N, bf16* WT, LAS float* scr, const LAS unsigned char* tab, float* sw, int s, int e, int wi, int nw, int lane) {
    int it = s + wi; if (it >= e) return;
    f32x4 cur[8]; transpose_load(W, N, it, lane, cur);
#pragma unroll 1
    for (; it < e; it += nw) { f32x4 nxt[8]; transpose_load(W, N, it + nw < e ? it + nw : it, lane, nxt);
        transpose_item<REMAP_UP, SW>(cur, K, N, WT, scr, tab, sw, it, lane);
#pragma unroll
        for (int i = 0; i < 8; ++i) cur[i] = nxt[i]; }
}
__device__ __forceinline__ void shift_frags(LAS unsigned char* tabB, const float* src, int tid) {
    for (int e = tid; e < 256 * 8; e += 512) { const int c = e >> 3, j = e & 7; v4u o = (v4u){0u, 0u, 0u, 0u};
        if (j < NCOND) { const f32x4 x0 = *(const GAS f32x4*)(src + (size_t)j * NMODC + 8 * c), x1 = *(const GAS f32x4*)(src + (size_t)j * NMODC + 8 * c + 4);
            o.x = pk2(x0[0], x0[1]); o.y = pk2(x0[2], x0[3]); o.z = pk2(x1[0], x1[1]); o.w = pk2(x1[2], x1[3]); }
        *(LAS v4u*)(tabB + e * 16) = o; }
}
constexpr int I_IN = (DM / 64) * (DIN / 32), I_OUT = (DM / 64) * (DM / 32), I_UP = (DM / 64) * (DUP / 32), I_DN = (DFF / 64) * (DM / 32), I_LAYER = I_IN + I_OUT + I_DN + I_UP;
__device__ __forceinline__ void convert_weights(ArgP a, LAS unsigned char* lds, int l, int lo, int hi, int wi, int nw, int tid) {
    asm volatile("" : "+v"(tid));
    const int lane = tid & 63, wave = __builtin_amdgcn_readfirstlane(tid >> 6);
    unsigned char* ws = a->ws; LAS float* scr = (LAS float*)(lds + wave * 8704); LAS unsigned char* tab = lds + 73728;
    const float* modl = (const float*)(ws + WS_MOD) + (size_t)l * NCOND * NMODC;
    int b0 = 0;
    { const int s = lo > b0 ? lo - b0 : 0, e = (hi < b0 + I_IN ? hi : b0 + I_IN) - b0;
        if (s < e) { __syncthreads(); shift_frags(tab, modl, tid); __syncthreads();
            transpose_range<false, true>(a->in[9] + (size_t)l * DM * DIN, DM, DIN, (bf16*)(ws + WS_WIN) + (size_t)l * DIN * DM, scr, tab, (float*)(ws + WS_SWIN) + (size_t)l * NCOND * DIN, s, e, wi, nw, lane); } }
    b0 += I_IN;
    { const int s = lo > b0 ? lo - b0 : 0, e = (hi < b0 + I_OUT ? hi : b0 + I_OUT) - b0;
        transpose_range<false, false>(a->in[10] + (size_t)l * DM * DM, DM, DM, (bf16*)(ws + WS_WOUT) + (size_t)l * DM * DM, scr, tab, nullptr, s, e, wi, nw, lane); }
    b0 += I_OUT;
    { const int s = lo > b0 ? lo - b0 : 0, e = (hi < b0 + I_DN ? hi : b0 + I_DN) - b0;
        transpose_range<false, false>(a->in[17] + (size_t)l * DFF * DM, DFF, DM, (bf16*)(ws + WS_WDN) + (size_t)l * DM * DFF, scr, tab, nullptr, s, e, wi, nw, lane); }
    b0 += I_DN;
    { const int s = lo > b0 ? lo - b0 : 0, e = (hi < b0 + I_UP ? hi : b0 + I_UP) - b0;
        if (s < e) { __syncthreads(); shift_frags(tab, modl + 3 * DM, tid); __syncthreads();
            transpose_range<true, true>(a->in[14] + (size_t)l * DM * DUP, DM, DUP, (bf16*)(ws + WS_WUP) + (size_t)l * DUP * DM, scr, tab, (float*)(ws + WS_SWUP) + (size_t)l * NCOND * DUP, s, e, wi, nw, lane); } }
    __syncthreads();
}

__device__ __forceinline__ void phase_prologue_a(ArgP a, LAS unsigned char* lds) {
    a = launder(a); const Ids I = make_ids(); const int tid = I.tid, lane = I.lane, wave = I.wave, gw = I.gw, NGW = I.NGW;
    unsigned char* ws = a->ws;
    LAS float* tab = (LAS float*)(lds + 73728);
    for (int i = tid; i < NCOND * DM; i += 512) { const int j = i / DM, k = i % DM; const float x = (j == 0) ? a->in[6][k] : a->in[5][(j - 1) * DM + k]; tab[i] = silu_f(x); }
    __syncthreads();
    {
        float* modp = (float*)(ws + WS_MODP);
        typedef float f32x2 __attribute__((ext_vector_type(2)));
        constexpr int NCB = NMODC / 128, NIT = DEPTH * KCH * NCB, RB = 16, NRB = 128 / RB;
        if (gw < NIT) {
            f32x2 acc[NCOND], wa[RB], wb[RB];
#pragma unroll
            for (int j = 0; j < NCOND; ++j) acc[j] = (f32x2){0.f, 0.f};
#define MOD_LOAD(buf, it_, r_) do { const float* W_ = a->in[7] + ((size_t)((it_) / (NCB * KCH)) * DM + (size_t)(((it_) / NCB) % KCH) * 128 + (size_t)(r_) * RB) * NMODC + ((it_) % NCB) * 128 + lane * 2; \
            _Pragma("unroll") for (int i_ = 0; i_ < RB; ++i_) buf[i_] = __builtin_nontemporal_load((const GAS f32x2*)(W_ + (size_t)i_ * NMODC)); } while (0)
#define MOD_ACC(buf, it_, r_) do { const int kc_ = ((it_) / NCB) % KCH, kb_ = kc_ * 128 + (r_) * RB; \
            _Pragma("unroll") for (int i_ = 0; i_ < RB; ++i_) { _Pragma("unroll") for (int j = 0; j < NCOND; ++j) acc[j] += tab[j * DM + kb_ + i_] * buf[i_]; } \
            if ((r_) == NRB - 1) { const int cb_ = (it_) % NCB, l_ = (it_) / (NCB * KCH); \
                _Pragma("unroll") for (int j = 0; j < NCOND; ++j) { *(GAS f32x2*)(modp + ((size_t)(kc_ * DEPTH + l_) * NCOND + j) * NMODC + cb_ * 128 + lane * 2) = acc[j]; acc[j] = (f32x2){0.f, 0.f}; } } } while (0)
            int it = gw, r = 0;
            MOD_LOAD(wa, it, r);
#pragma unroll 1
            for (;;) {
                int nit = it, nr = r + 1; if (nr == NRB) { nr = 0; nit = it + NGW; }
                bool has = nit < NIT;
                if (has) MOD_LOAD(wb, nit, nr);
                MOD_ACC(wa, it, r);
                if (!has) break;
                it = nit; r = nr;
                nr = r + 1; if (nr == NRB) { nr = 0; nit = it + NGW; }
                has = nit < NIT;
                if (has) MOD_LOAD(wa, nit, nr);
                MOD_ACC(wb, it, r);
                if (!has) break;
                it = nit; r = nr;
            }
#undef MOD_LOAD
#undef MOD_ACC
        }
    }
    const int gt = gw * 64 + lane, NGT = NGW * 64;
    { float* swz = (float*)(ws + WS_SWIN); for (int i = gt; i < (int)((2 * MiB) / 4); i += NGT) swz[i] = 0.f; }
    {
        float* rope = (float*)(ws + WS_ROPE);
        for (int i = gt; i < SEQ_S * 32; i += NGT) { const int t = i >> 5, k = i & 31;
            const float inv = exp2f(-(float)k * (13.287712379549449f / 32.f));
            const float rr = (float)(t >> 6) * inv * 0.15915494309189535f, rc = (float)(t & 63) * inv * 0.15915494309189535f;
            const float fr_ = rr - floorf(rr), fc_ = rc - floorf(rc);
            rope[t * 128 + k] = __builtin_amdgcn_cosf(fr_); rope[t * 128 + 32 + k] = __builtin_amdgcn_sinf(fr_);
            rope[t * 128 + 64 + k] = __builtin_amdgcn_cosf(fc_); rope[t * 128 + 96 + k] = __builtin_amdgcn_sinf(fc_); }
    }
    {
        constexpr int NC8 = NB_S * DEPTH * HKV * PAST * HD / 8;
        for (int i0 = gt; i0 < 2 * NC8; i0 += 4 * NGT) {
            f32x4 x0[4], x1[4];
#pragma unroll
            for (int q = 0; q < 4; ++q) { const int i = i0 + q * NGT; if (i < 2 * NC8) { const bool isk = i < NC8; const int j = isk ? i : i - NC8;
                const float* src = (isk ? a->in[2] : a->in[3]) + (size_t)j * 8; x0[q] = *(const GAS f32x4*)src; x1[q] = *(const GAS f32x4*)(src + 4); } }
#pragma unroll
            for (int q = 0; q < 4; ++q) { const int i = i0 + q * NGT; if (i < 2 * NC8) { const bool isk = i < NC8; const int j = isk ? i : i - NC8;
                v4u o; o.x = pk2(x0[q][0], x0[q][1]); o.y = pk2(x0[q][2], x0[q][3]); o.z = pk2(x1[q][0], x1[q][1]); o.w = pk2(x1[q][2], x1[q][3]);
                *(GAS v4u*)((bf16*)(ws + (isk ? WS_CKB : WS_CVB)) + (size_t)j * 8) = o; } }
        }
    }
}
__device__ __forceinline__ void phase_prologue_b(ArgP a) {
    a = launder(a); const Ids I = make_ids(); const int gt = I.gt, NGT = I.NGT;
    const float* modp = (const float*)(a->ws + WS_MODP); float* mod = (float*)(a->ws + WS_MOD);
    constexpr int N4 = DEPTH * NCOND * NMODC / 4;
    for (int i = gt; i < N4; i += NGT) { const int c4 = i % (NMODC / 4), lj = i / (NMODC / 4), l = lj / NCOND, j = lj % NCOND;
        f32x4 s = *(const GAS f32x4*)(a->in[8] + (size_t)l * NMODC + c4 * 4);
#pragma unroll
        for (int kc = 0; kc < KCH; ++kc) s += *(const GAS f32x4*)(modp + ((size_t)(kc * DEPTH + l) * NCOND + j) * NMODC + c4 * 4);
        *(GAS f32x4*)(mod + (size_t)lj * NMODC + c4 * 4) = s; }
}
typedef float f32x16p __attribute__((ext_vector_type(16)));
__device__ __forceinline__ void phase_prologue_c(ArgP a, LAS unsigned char* lds) {
    a = launder(a); const Ids I = make_ids(); const int lane = I.lane, gw = I.gw, NGW = I.NGW;
    unsigned char* ws = a->ws;
    convert_weights(a, lds, 0, 0, I_LAYER, gw, NGW, I.tid);
    bf16* XS = (bf16*)(ws + WS_H); float* rss = (float*)(ws + WS_RSS1);
    if (gw < MTOK) {
        f32x4 v[8], w[8];
#define XROW(m_) ((const GAS f32x4*)((m_) < MP ? a->in[0] + (size_t)(m_) * DM : a->in[1] + (size_t)((m_) - MP) * DM) + lane)
        { const GAS f32x4* xr = XROW(gw);
#pragma unroll
            for (int j = 0; j < 8; ++j) v[j] = xr[64 * j]; }
#pragma unroll 1
        for (int m = gw; m < MTOK; m += NGW) {
            { const int mn = m + NGW < MTOK ? m + NGW : m; const GAS f32x4* xr = XROW(mn);
#pragma unroll
                for (int j = 0; j < 8; ++j) w[j] = xr[64 * j]; }
            const float* sc = (const float*)(ws + WS_MOD) + (size_t)cond_of_row(m) * NMODC + DM;
            float s = 0.f;
#pragma unroll
            for (int j = 0; j < 8; ++j) s += (v[j].x * v[j].x + v[j].y * v[j].y) + (v[j].z * v[j].z + v[j].w * v[j].w);
            s = wave_sum(s, lane); if (lane == 0) rss[m] = s;
            GAS unsigned long long* o8 = (GAS unsigned long long*)(XS + (size_t)m * DM) + lane;
#pragma unroll
            for (int j = 0; j < 8; ++j) { const f32x4 h = v[j] * (*(const GAS f32x4*)(sc + (lane + 64 * j) * 4) + 1.f);
                o8[64 * j] = (unsigned long long)pk2(h.x, h.y) | ((unsigned long long)pk2(h.z, h.w) << 32); }
#pragma unroll
            for (int j = 0; j < 8; ++j) v[j] = w[j];
        }
#undef XROW
    }
}
__device__ __forceinline__ void zero_f32(float* p, int n, int gt, int NGT) { for (int i = gt; i < n; i += NGT) p[i] = 0.f; }
__device__ __forceinline__ void phase_final(ArgP a) {
    a = launder(a); const Ids I = make_ids(); const int lane = I.lane, gw = I.gw, NGW = I.NGW;
    const float* X = (const float*)(a->ws + WS_X); const float* gain = a->in[18];
    if (gw < MTOK) {
        f32x4 v[8], w[8];
        { const GAS f32x4* xr = (const GAS f32x4*)(X + (size_t)gw * DM) + lane;
#pragma unroll
            for (int j = 0; j < 8; ++j) v[j] = xr[64 * j]; }
#pragma unroll 1
        for (int m = gw; m < MTOK; m += NGW) {
            { const int mn = m + NGW < MTOK ? m + NGW : m; const GAS f32x4* xr = (const GAS f32x4*)(X + (size_t)mn * DM) + lane;
#pragma unroll
                for (int j = 0; j < 8; ++j) w[j] = xr[64 * j]; }
            float s = 0.f;
#pragma unroll
            for (int j = 0; j < 8; ++j) s += (v[j].x * v[j].x + v[j].y * v[j].y) + (v[j].z * v[j].z + v[j].w * v[j].w);
            const float r = 1.f / sqrtf(wave_sum(s, lane) * (1.f / DM) + EPS);
            GAS f32x4* o = (GAS f32x4*)(a->out + OUT_Y + (size_t)m * DM) + lane;
#pragma unroll
            for (int j = 0; j < 8; ++j) o[64 * j] = v[j] * r * *(const GAS f32x4*)(gain + (lane + 64 * j) * 4);
#pragma unroll
            for (int j = 0; j < 8; ++j) v[j] = w[j];
        }
    }
}
namespace pg8 {
struct EpiUp {
    static constexpr bool PERM = true, AFTER_DRAIN = false;
    bf16_t* O; const float* rss; const float* sw;
    __device__ __forceinline__ void operator()(const f32x4 (&acc)[2][2][4][2], const Unit& u, int wr, int wc, int fr, int fq) const {
        const int row0 = u.pm * BM + wr * 64 + fr, col0 = u.pn * BM + wc * 32 + 8 * fq;
        const int cond = u.pm < MP / BM ? 0 : 1 + ((u.pm - MP / BM) >> 2);
        f32x4 sv[2][2];
#pragma unroll
        for (int bj = 0; bj < 2; ++bj)
#pragma unroll
            for (int n = 0; n < 2; ++n) sv[bj][n] = *(const f32x4*)(sw + (size_t)cond * DUP + col0 + bj * HALF + 4 * n);
#pragma unroll
        for (int ai = 0; ai < 2; ++ai)
#pragma unroll
            for (int m = 0; m < 4; ++m) { const int row = row0 + ai * HALF + m * 16; const float r = 1.f / sqrtf(rss[row] * (1.f / DM) + EPS);
                bf16_t* rowp = O + (size_t)row * DUP + col0;
#pragma unroll
                for (int bj = 0; bj < 2; ++bj) { const f32x4 v0 = acc[ai][bj][m][0] * r + sv[bj][0], v1 = acc[ai][bj][m][1] * r + sv[bj][1];
                    u32x4 w; w.x = cvt_pk_bf16(v0[0], v0[1]); w.y = cvt_pk_bf16(v0[2], v0[3]); w.z = cvt_pk_bf16(v1[0], v1[1]); w.w = cvt_pk_bf16(v1[2], v1[3]);
                    *(u32x4*)(rowp + bj * HALF) = w; } }
    }
};
template <int CTRL> __device__ __forceinline__ float dpp1(float old, float src) { return __builtin_bit_cast(float, __builtin_amdgcn_update_dpp(__builtin_bit_cast(int, old), __builtin_bit_cast(int, src), CTRL, 0xf, 0xf, false)); }
template <bool SHR> __device__ __forceinline__ f32x4 dpp4(f32x4 old, f32x4 src) {
    f32x4 r; r.x = dpp1<SHR ? 0x111 : 0x101>(old.x, src.x); r.y = dpp1<SHR ? 0x111 : 0x101>(old.y, src.y); r.z = dpp1<SHR ? 0x111 : 0x101>(old.z, src.z); r.w = dpp1<SHR ? 0x111 : 0x101>(old.w, src.w); return r; }
template <int CTRL> __device__ __forceinline__ float dppm1(float src) { return __builtin_bit_cast(float, __builtin_amdgcn_mov_dpp(__builtin_bit_cast(int, src), CTRL, 0xf, 0xf, false)); }
__device__ __forceinline__ f32x4 ror1_4(f32x4 x) { f32x4 r; r.x = dppm1<0x121>(x.x); r.y = dppm1<0x121>(x.y); r.z = dppm1<0x121>(x.z); r.w = dppm1<0x121>(x.w); return r; }
__device__ __forceinline__ f32x4 rol1_4(f32x4 x) { f32x4 r; r.x = dppm1<0x12F>(x.x); r.y = dppm1<0x12F>(x.y); r.z = dppm1<0x12F>(x.z); r.w = dppm1<0x12F>(x.w); return r; }
struct EpiUpConv {
    static constexpr bool PERM = true, AFTER_DRAIN = false;
    bf16_t* ACT; const float* rss; const float* sw; const float* cw; const float* cb; float* halo; PG8_LAS float* ex;
    __device__ __forceinline__ void operator()(const f32x4 (&acc)[2][2][4][2], const Unit& u, int wr, int wc, int fr, int fq) const {
        const int rowb = u.pm * BM + wr * 64 + fr, colt = u.pn * BM + wc * 32 + 8 * fq, ocol = u.pn * HALF + wc * 32 + 8 * fq;
        const bool ctx = u.pm < MP / BM; const int st = u.pm - MP / BM, cond = ctx ? 0 : 1 + (st >> 2);
        const bool has_above = !ctx && (st & 3) != 0, has_below = !ctx && (st & 3) != 3;
        float r[2][4]; f32x4 sv[2][2];
#pragma unroll
        for (int ai = 0; ai < 2; ++ai)
#pragma unroll
            for (int m = 0; m < 4; ++m) r[ai][m] = 1.f / sqrtf(rss[rowb + ai * HALF + m * 16] * (1.f / DM) + EPS);
#pragma unroll
        for (int bj = 0; bj < 2; ++bj)
#pragma unroll
            for (int n = 0; n < 2; ++n) sv[bj][n] = *(const f32x4*)(sw + (size_t)cond * DUP + colt + bj * HALF + 4 * n);
#define NRM(ai, bj, m, n) (acc[ai][bj][m][n] * r[ai][m] + sv[bj][n])
        if (fr == 0 || fr == 15) { const int edge = fr == 0 ? 0 : 1;
#pragma unroll
            for (int ai = 0; ai < 2; ++ai)
#pragma unroll
                for (int bj = 0; bj < 2; ++bj)
#pragma unroll
                    for (int n = 0; n < 2; ++n) { const f32x4 v = edge ? NRM(ai, bj, 3, n) : NRM(ai, bj, 0, n);
                        *(PG8_LAS f32x4*)(ex + ((((wr * 4 + wc) * 2 + ai) * 2 + edge) * 2 + bj) * 32 + fq * 8 + n * 4) = v; } }
        if (has_above && wr == 0 && fr < 2) {
#pragma unroll
            for (int bj = 0; bj < 2; ++bj)
#pragma unroll
                for (int n = 0; n < 2; ++n) *(f32x4*)(halo + (size_t)((st * 2 + 0) * 2 + fr) * DUP + colt + bj * HALF + 4 * n) = NRM(0, bj, 0, n); }
        if (has_below && wr == 1 && fr >= 14) {
#pragma unroll
            for (int bj = 0; bj < 2; ++bj)
#pragma unroll
                for (int n = 0; n < 2; ++n) *(f32x4*)(halo + (size_t)((st * 2 + 1) * 2 + (fr - 14)) * DUP + colt + bj * HALF + 4 * n) = NRM(1, bj, 3, n); }
        asm volatile("s_waitcnt lgkmcnt(0)" ::: "memory"); __builtin_amdgcn_s_barrier(); asm volatile("" ::: "memory");
        typedef unsigned u32x2v __attribute__((ext_vector_type(2)));
        u32x2v outp[2][4][2];
        const f32x4 z4 = {0.f, 0.f, 0.f, 0.f};
#pragma unroll
        for (int n = 0; n < 2; ++n) {
            f32x4 wg[3], wv[3];
#pragma unroll
            for (int j = 0; j < 3; ++j) { wg[j] = *(const f32x4*)(cw + (size_t)j * DUP + ocol + 4 * n); wv[j] = *(const f32x4*)(cw + (size_t)j * DUP + DFF + ocol + 4 * n); }
            const f32x4 bg = *(const f32x4*)(cb + ocol + 4 * n), bvv = *(const f32x4*)(cb + DFF + ocol + 4 * n);
#pragma unroll
            for (int ai = 0; ai < 2; ++ai) {
                f32x4 tg[4], tv[4];
#pragma unroll
                for (int m = 0; m < 4; ++m) { tg[m] = NRM(ai, 0, m, n); tv[m] = NRM(ai, 1, m, n); }
                f32x4 ag = z4, av = z4, lg = z4, lv = z4;
                { int sw_ = -1, sa_ = 0;
                    if (wr == 1) { sw_ = 0; sa_ = ai; } else if (ai == 1) { sw_ = 1; sa_ = 0; }
                    if (sw_ >= 0) { const PG8_LAS float* q = ex + ((((sw_ * 4 + wc) * 2 + sa_) * 2 + 1) * 2) * 32 + fq * 8 + n * 4; ag = *(const PG8_LAS f32x4*)q; av = *(const PG8_LAS f32x4*)(q + 32); }
                    int tw_ = -1, ta_ = 0;
                    if (wr == 0) { tw_ = 1; ta_ = ai; } else if (ai == 0) { tw_ = 0; ta_ = 1; }
                    if (tw_ >= 0) { const PG8_LAS float* q = ex + ((((tw_ * 4 + wc) * 2 + ta_) * 2 + 0) * 2) * 32 + fq * 8 + n * 4; lg = *(const PG8_LAS f32x4*)q; lv = *(const PG8_LAS f32x4*)(q + 32); } }
#pragma unroll
                for (int m = 0; m < 4; ++m) {
                    const f32x4 pg = dpp4<true>(m == 0 ? ag : ror1_4(tg[m == 0 ? 0 : m - 1]), tg[m]), pv = dpp4<true>(m == 0 ? av : ror1_4(tv[m == 0 ? 0 : m - 1]), tv[m]);
                    const f32x4 ng = dpp4<false>(m == 3 ? lg : rol1_4(tg[m == 3 ? 3 : m + 1]), tg[m]), nv = dpp4<false>(m == 3 ? lv : rol1_4(tv[m == 3 ? 3 : m + 1]), tv[m]);
                    const f32x4 ug = bg + wg[0] * pg + wg[1] * tg[m] + wg[2] * ng, uv = bvv + wv[0] * pv + wv[1] * tv[m] + wv[2] * nv;
                    f32x4 o;
#pragma unroll
                    for (int e = 0; e < 4; ++e) o[e] = ug[e] * __builtin_amdgcn_rcpf(1.f + __builtin_amdgcn_exp2f(-1.4426950408889634f * ug[e])) * uv[e];
                    outp[ai][m][n].x = cvt_pk_bf16(o[0], o[1]); outp[ai][m][n].y = cvt_pk_bf16(o[2], o[3]);
                }
            }
        }
#undef NRM
#pragma unroll
        for (int ai = 0; ai < 2; ++ai)
#pragma unroll
            for (int m = 0; m < 4; ++m) { u32x4 w; w.x = outp[ai][m][0].x; w.y = outp[ai][m][0].y; w.z = outp[ai][m][1].x; w.w = outp[ai][m][1].y;
                *(u32x4*)(ACT + (size_t)(rowb + ai * HALF + m * 16) * DFF + ocol) = w; }
    }
};
struct EpiIn {
    static constexpr bool PERM = true, AFTER_DRAIN = false;
    bf16_t* O; float* ck; float* cv; int layer; const float* rss; const float* sw;
    __device__ __forceinline__ void operator()(const f32x4 (&acc)[2][2][4][2], const Unit& u, int wr, int wc, int fr, int fq) const {
        const int row0 = u.pm * BM + u.h * HALF + wr * 64 + fr, col0 = u.pn * BM + wc * 32 + 8 * fq;
        const int cond = u.pm < MP / BM ? 0 : 1 + ((u.pm - MP / BM) >> 2);
        const bool cache = (u.pn >= C_KA / BM && u.pm < MP / BM); float* dst = (u.pn == C_KA / BM) ? ck : cv;
        f32x4 sv[2][2];
#pragma unroll
        for (int bj = 0; bj < 2; ++bj)
#pragma unroll
            for (int n = 0; n < 2; ++n) sv[bj][n] = *(const f32x4*)(sw + (size_t)cond * DIN + col0 + bj * HALF + 4 * n);
#pragma unroll
        for (int ai = 0; ai < 2; ++ai) { if (ai == 1 && u.half) break;
#pragma unroll
            for (int m = 0; m < 4; ++m) { const int row = row0 + ai * HALF + m * 16; const float r = 1.f / sqrtf(rss[row] * (1.f / DM) + EPS);
                bf16_t* rowp = O + (size_t)row * DIN + col0;
#pragma unroll
                for (int bj = 0; bj < 2; ++bj) { const f32x4 v0 = acc[ai][bj][m][0] * r + sv[bj][0], v1 = acc[ai][bj][m][1] * r + sv[bj][1];
                    u32x4 w; w.x = cvt_pk_bf16(v0[0], v0[1]); w.y = cvt_pk_bf16(v0[2], v0[3]); w.z = cvt_pk_bf16(v1[0], v1[1]); w.w = cvt_pk_bf16(v1[2], v1[3]);
                    *(u32x4*)(rowp + bj * HALF) = w;
                    if (cache) { float* p = dst + ((((size_t)(row >> 8) * DEPTH + layer) * HKV + bj) * SEQ_P + (row & 255)) * HD + wc * 32 + 8 * fq; __builtin_nontemporal_store(v0, (f32x4*)p); __builtin_nontemporal_store(v1, (f32x4*)(p + 4)); } } } }
    }
};
#ifndef EPIRES_MH
#define EPIRES_MH 2
#endif
struct EpiRes {
    static constexpr bool PERM = false, AFTER_DRAIN = false;
    const float* xin_p; const float* xin_s; float* X; const float* gate; const float* scale_next; bf16_t* XS; float* rss; int dry; const float* slab;
    __device__ __forceinline__ void operator()(const f32x4 (&acc)[2][2][4][2], const Unit& u, int wr, int wc, int fr, int fq) const {
        if (dry) return;
        asm volatile("" : "+v"(fr), "+v"(fq));
        const int row0 = u.pm * BM + u.h * HALF + wr * 64 + fr, col0 = u.pn * BM + wc * 32 + 4 * fq;
        const bool ctx = u.pm < MP / BM; const int cond = ctx ? 0 : 1 + ((u.pm - MP / BM) >> 2);
        const float* xin = ctx ? xin_p : xin_s - (size_t)MP * DM;
        const float* g = gate + (size_t)cond * NMODC + col0;
        const float* part = u.part ? slab + (size_t)u.slab * 65536 + (size_t)u.h * 32768 + (size_t)(((wr * 4 + wc) * 4 + fq) * 16 + fr) * 4 : nullptr;
        const int xsperm = (fq & 1) * 16 + (fq >> 1) * 8 - 4 * fq;
        f32x4 gv[2][2], sv[2][2];
#pragma unroll
        for (int bj = 0; bj < 2; ++bj)
#pragma unroll
            for (int n = 0; n < 2; ++n) { gv[bj][n] = *(const f32x4*)(g + bj * HALF + n * 16); sv[bj][n] = scale_next ? *(const f32x4*)(scale_next + (size_t)cond * NMODC + col0 + bj * HALF + n * 16) + 1.f : (f32x4){1.f, 1.f, 1.f, 1.f}; }
#pragma unroll
        for (int ai = 0; ai < 2; ++ai) { if (ai == 1 && u.half) break;
#pragma unroll
          for (int mh = 0; mh < EPIRES_MH; ++mh) {
            f32x4 xv[4][2][2];
#pragma unroll
            for (int m = (4 / EPIRES_MH) * mh; m < (4 / EPIRES_MH) * (mh + 1); ++m)
#pragma unroll
                for (int bj = 0; bj < 2; ++bj)
#pragma unroll
                    for (int n = 0; n < 2; ++n) xv[m][bj][n] = *(const f32x4*)(xin + (size_t)(row0 + ai * HALF + m * 16) * DM + col0 + bj * HALF + n * 16);
#pragma unroll
            for (int m = (4 / EPIRES_MH) * mh; m < (4 / EPIRES_MH) * (mh + 1); ++m) { const int row = row0 + ai * HALF + m * 16; const size_t off = (size_t)row * DM + col0; float ss = 0.f;
#pragma unroll
                for (int bj = 0; bj < 2; ++bj) { unsigned wx[2], wy[2];
#pragma unroll
                    for (int n = 0; n < 2; ++n) { const size_t o = off + bj * HALF + n * 16; f32x4 av = acc[ai][bj][m][n]; if (part) av = (u.h ? acc[1][bj][m][n] : acc[0][bj][m][n]) + *(const f32x4*)(part + ((bj * 4 + m) * 2 + n) * 2048);
                        const f32x4 x = xv[m][bj][n] + gv[bj][n] * av; *(f32x4*)(X + o) = x;
                        if (scale_next) { ss += (x[0] * x[0] + x[1] * x[1]) + (x[2] * x[2] + x[3] * x[3]); const f32x4 h = x * sv[bj][n]; wx[n] = cvt_pk_bf16(h[0], h[1]); wy[n] = cvt_pk_bf16(h[2], h[3]); } }
                    if (scale_next) {
                        const auto rx = __builtin_amdgcn_permlane16_swap(wx[0], wx[1], false, false), ry = __builtin_amdgcn_permlane16_swap(wy[0], wy[1], false, false);
                        u32x4 w4; w4.x = rx[0]; w4.y = ry[0]; w4.z = rx[1]; w4.w = ry[1];
                        *(u32x4*)(XS + off + bj * HALF + xsperm) = w4; } }
                if (scale_next) { { const int ln = fq * 16 + fr; ss += shx(ss, 16, ln); ss += shx(ss, 32, ln); } if (fq == 0) unsafeAtomicAdd(rss + row, ss); } }
            asm volatile("" ::: "memory"); } }
    }
};
}

__device__ __forceinline__ void unpack8(v4u w, float (&f)[8]) { f[0] = bflo(w.x); f[1] = bfhi(w.x); f[2] = bflo(w.y); f[3] = bfhi(w.y); f[4] = bflo(w.z); f[5] = bfhi(w.z); f[6] = bflo(w.w); f[7] = bfhi(w.w); }
__device__ __forceinline__ f32x4 silu4_mul(f32x4 g, f32x4 v) { f32x4 o;
#pragma unroll
    for (int e = 0; e < 4; ++e) o[e] = g[e] * __builtin_amdgcn_rcpf(1.f + __builtin_amdgcn_exp2f(-LOG2E * g[e])) * v[e]; return o; }
__device__ __forceinline__ void phase_convfix(ArgP a, int l) {
    a = launder(a); const Ids I = make_ids();
    const float* halo = (const float*)(a->ws + WS_HALO); bf16* ACT = (bf16*)(a->ws + WS_ACT);
    const float* cw = a->in[15] + (size_t)l * 3 * DUP; const float* cb = a->in[16] + (size_t)l * DUP;
    for (int idx = I.gt; idx < 12 * (DFF / 4); idx += I.NGT) {
        const int bd = idx / (DFF / 4), ocol = (idx % (DFF / 4)) * 4, st = (bd / 3) * 4 + bd % 3, gcol = (ocol >> 7) * 256 + (ocol & 127);
        const float* hu = halo + (size_t)((st * 2 + 1) * 2) * DUP; const float* hl = halo + (size_t)(((st + 1) * 2 + 0) * 2) * DUP;
        const f32x4 Ag = *(const GAS f32x4*)(hu + gcol), Bg = *(const GAS f32x4*)(hu + DUP + gcol), Cg = *(const GAS f32x4*)(hl + gcol), Dg = *(const GAS f32x4*)(hl + DUP + gcol);
        const f32x4 Av = *(const GAS f32x4*)(hu + gcol + 128), Bv = *(const GAS f32x4*)(hu + DUP + gcol + 128), Cv = *(const GAS f32x4*)(hl + gcol + 128), Dv = *(const GAS f32x4*)(hl + DUP + gcol + 128);
        f32x4 wg[3], wv[3];
#pragma unroll
        for (int j = 0; j < 3; ++j) { wg[j] = *(const GAS f32x4*)(cw + (size_t)j * DUP + ocol); wv[j] = *(const GAS f32x4*)(cw + (size_t)j * DUP + DFF + ocol); }
        const f32x4 bg = *(const GAS f32x4*)(cb + ocol), bv = *(const GAS f32x4*)(cb + DFF + ocol);
        const f32x4 o255 = silu4_mul(bg + wg[0] * Ag + wg[1] * Bg + wg[2] * Cg, bv + wv[0] * Av + wv[1] * Bv + wv[2] * Cv);
        const f32x4 o0 = silu4_mul(bg + wg[0] * Bg + wg[1] * Cg + wg[2] * Dg, bv + wv[0] * Bv + wv[1] * Cv + wv[2] * Dv);
        v2u w; w.x = pk2(o255[0], o255[1]); w.y = pk2(o255[2], o255[3]); *(GAS v2u*)(ACT + (size_t)(MP + st * 256 + 255) * DFF + ocol) = w;
        w.x = pk2(o0[0], o0[1]); w.y = pk2(o0[2], o0[3]); *(GAS v2u*)(ACT + (size_t)(MP + (st + 1) * 256) * DFF + ocol) = w;
    }
}

typedef float f32x16 __attribute__((ext_vector_type(16)));
typedef short s16x4 __attribute__((ext_vector_type(4)));
#define KSWZ(row, colB) ((row) * 256 + ((colB) ^ (((row) & 7) << 4)))
#define SBAR() __builtin_amdgcn_sched_barrier(0)
__device__ __forceinline__ int crow(int r, int hi) { return (r & 3) + 8 * (r >> 2) + 4 * hi; }
__device__ __forceinline__ unsigned cvtpk(float lo, float hi) { unsigned r; asm volatile("v_cvt_pk_bf16_f32 %0, %1, %2" : "=v"(r) : "v"(lo), "v"(hi)); return r; }
__device__ __forceinline__ int v_st(int k, int c) { const int kk = (k & ~0xC) | ((k & 4) << 1) | ((k & 8) >> 1); return ((kk >> 3) * 4 + (c >> 5)) * 512 + ((kk & 7) * 32 + (c & 31)) * 2; }
__device__ __forceinline__ int v_rd_base(int lane) { return ((lane & 3) << 3) | (((lane >> 2) & 3) << 6) | (((lane >> 4) & 1) << 5) | (((lane >> 5) & 1) << 8); }
constexpr int v_rd_off(int d0, int ks, int half) { return d0 * 512 + ks * 4096 + half * 2048; }
template <int OFF> __device__ __forceinline__ s16x4 tr_read(int vb) { s16x4 r; asm volatile("ds_read_b64_tr_b16 %0, %1 offset:%2" : "=&v"(r) : "v"(vb), "i"(OFF) : "memory"); return r; }
#define PKLH(L, H) (bf16x8){L[0], L[1], L[2], L[3], H[0], H[1], H[2], H[3]}
template <int D0> __device__ __forceinline__ void pv_one(f32x16& od, int vb, bf16x8 pa0, bf16x8 pa1, bf16x8 pa2, bf16x8 pa3) {
    const s16x4 l0 = tr_read<v_rd_off(D0, 0, 0)>(vb), h0 = tr_read<v_rd_off(D0, 0, 1)>(vb), l1 = tr_read<v_rd_off(D0, 1, 0)>(vb), h1 = tr_read<v_rd_off(D0, 1, 1)>(vb);
    const s16x4 l2 = tr_read<v_rd_off(D0, 2, 0)>(vb), h2 = tr_read<v_rd_off(D0, 2, 1)>(vb), l3 = tr_read<v_rd_off(D0, 3, 0)>(vb), h3 = tr_read<v_rd_off(D0, 3, 1)>(vb);
    asm volatile("s_waitcnt lgkmcnt(0)" ::: "memory"); SBAR();
    od = __builtin_amdgcn_mfma_f32_32x32x16_bf16(pa0, PKLH(l0, h0), od, 0, 0, 0);
    od = __builtin_amdgcn_mfma_f32_32x32x16_bf16(pa1, PKLH(l1, h1), od, 0, 0, 0);
    od = __builtin_amdgcn_mfma_f32_32x32x16_bf16(pa2, PKLH(l2, h2), od, 0, 0, 0);
    od = __builtin_amdgcn_mfma_f32_32x32x16_bf16(pa3, PKLH(l3, h3), od, 0, 0, 0);
}
__device__ __forceinline__ void pack_p(const f32x16& p0, const f32x16& p1, bf16x8& pa0, bf16x8& pa1, bf16x8& pa2, bf16x8& pa3) {
#define PK4(P, BASE, OUT) do { unsigned a0 = cvtpk(P[BASE + 0], P[BASE + 1]), a1 = cvtpk(P[BASE + 2], P[BASE + 3]);   \
    unsigned b0 = cvtpk(P[BASE + 4], P[BASE + 5]), b1 = cvtpk(P[BASE + 6], P[BASE + 7]);                              \
    auto r0 = __builtin_amdgcn_permlane32_swap(a0, b0, false, false); auto r1 = __builtin_amdgcn_permlane32_swap(a1, b1, false, false); \
    v4u w = {r0[0], r1[0], r0[1], r1[1]}; OUT = __builtin_bit_cast(bf16x8, w); } while (0)
    PK4(p0, 0, pa0); PK4(p0, 8, pa1); PK4(p1, 0, pa2); PK4(p1, 8, pa3);
#undef PK4
}
__device__ __forceinline__ void qkt(f32x16& p0, f32x16& p1, LAS const unsigned char* Ks, const bf16x8 (&qr)[8], int r32, int hi) {
    p0 = (f32x16){}; p1 = (f32x16){};
#pragma unroll
    for (int d0 = 0; d0 < 8; ++d0) { const int cb = (d0 * 16 + hi * 8) * 2;
        const bf16x8 b0 = *(LAS const bf16x8*)(Ks + KSWZ(r32, cb));
        const bf16x8 b1 = *(LAS const bf16x8*)(Ks + KSWZ(32 + r32, cb));
        p0 = __builtin_amdgcn_mfma_f32_32x32x16_bf16(b0, qr[d0], p0, 0, 0, 0);
        p1 = __builtin_amdgcn_mfma_f32_32x32x16_bf16(b1, qr[d0], p1, 0, 0, 0); }
}
constexpr float ATT_THR = 8.f;
__device__ __forceinline__ void partialSM(f32x16& p0, f32x16& p1, float& m_reg, float& alpha) {
    constexpr float C = QK_SCALE * LOG2E;
    float pmax = p0[0];
#pragma unroll
    for (int r = 1; r < 16; ++r) pmax = fmaxf(pmax, p0[r]);
#pragma unroll
    for (int r = 0; r < 16; ++r) pmax = fmaxf(pmax, p1[r]);
    { auto rr = __builtin_amdgcn_permlane32_swap(__float_as_uint(pmax), __float_as_uint(pmax), false, false); pmax = fmaxf(__uint_as_float(rr[0]), __uint_as_float(rr[1])); }
    float mn;
    if (__builtin_expect(__all(pmax - m_reg <= ATT_THR / QK_SCALE), 1)) { mn = m_reg; alpha = 1.f; }
    else { mn = fmaxf(m_reg, pmax); alpha = __builtin_amdgcn_exp2f((m_reg - mn) * C); m_reg = mn; }
    const float mnC = -mn * C;
#pragma unroll
    for (int r = 0; r < 16; ++r) p0[r] = fmaf(p0[r], C, mnC);
#pragma unroll
    for (int r = 0; r < 16; ++r) p1[r] = fmaf(p1[r], C, mnC);
#pragma unroll
    for (int r = 0; r < 16; ++r) p0[r] = __builtin_amdgcn_exp2f(p0[r]);
}
__device__ __forceinline__ void finishSM(f32x16& p0, f32x16& p1, float alpha, float& l_reg, bf16x8& pa0, bf16x8& pa1, bf16x8& pa2, bf16x8& pa3) {
#pragma unroll
    for (int r = 0; r < 16; ++r) p1[r] = __builtin_amdgcn_exp2f(p1[r]);
    float ps = 0.f;
#pragma unroll
    for (int r = 0; r < 16; ++r) ps += p0[r];
#pragma unroll
    for (int r = 0; r < 16; ++r) ps += p1[r];
    { auto rr = __builtin_amdgcn_permlane32_swap(__float_as_uint(ps), __float_as_uint(ps), false, false); ps = __uint_as_float(rr[0]) + __uint_as_float(rr[1]); }
    l_reg = l_reg * alpha + ps;
    pack_p(p0, p1, pa0, pa1, pa2, pa3);
}
__device__ __forceinline__ v4u rope8(v4u x, v4u y, bool first, const f32x4 (&cs)[2], const f32x4 (&sn)[2]) {
    float xf[8], yf[8], o[8]; unpack8(x, xf); unpack8(y, yf);
#pragma unroll
    for (int e = 0; e < 8; ++e) { const float c = cs[e >> 2][e & 3], s = sn[e >> 2][e & 3]; o[e] = first ? xf[e] * c - yf[e] * s : xf[e] * c + yf[e] * s; }
    v4u w; w.x = pk2(o[0], o[1]); w.y = pk2(o[2], o[3]); w.z = pk2(o[4], o[5]); w.w = pk2(o[6], o[7]); return w;
}

struct AttnTile { const bf16* kp; const bf16* vp; int stride; int tok; };
template <bool LATENT>
__device__ __forceinline__ void attn_unit(ArgP a, LAS unsigned char* lds, int l, int unit, int tid) {
    asm volatile("" : "+v"(tid));
    const int lane = tid & 63, wid = __builtin_amdgcn_readfirstlane(tid >> 6), r32 = lane & 31, hi = lane >> 5;
    const bf16* P = (const bf16*)(a->ws + WS_PROJ); bf16* MIX = (bf16*)(a->ws + WS_MIX);
    const float* rope = (const float*)(a->ws + WS_ROPE);
    int b, head, t0, row0, nt_win, tok_lo;
    if (LATENT) { b = unit >> 5; head = (unit >> 2) & 7; const int qb = unit & 3; t0 = qb * 256; row0 = MP + b * SEQ_S + t0;
        tok_lo = t0 - 128 < 0 ? 0 : t0 - 128; const int tok_hi = t0 + 384 > SEQ_S ? SEQ_S : t0 + 384; nt_win = (tok_hi - tok_lo) >> 6; }
    else { b = unit >> 3; head = unit & 7; t0 = 0; row0 = b * SEQ_P; nt_win = 0; tok_lo = 0; }
    const int hkv = head >> 2, NT = LATENT ? nt_win + PAST / 64 : SEQ_P / 64;
    LAS unsigned char* Vl = lds; LAS unsigned char* Kl = lds + 16384; LAS float* wsc = (LAS float*)(lds + 32768 + 256 * wid);
    bf16x8 qr[8];
    { const bf16* Qw = P + (size_t)(row0 + wid * 32 + r32) * DIN + C_QA + head * HD + hi * 8;
        v4u q[8];
#pragma unroll
        for (int d0 = 0; d0 < 8; ++d0) q[d0] = *(const GAS v4u*)(Qw + d0 * 16);
        if (LATENT) { const float* rt = rope + (size_t)(t0 + wid * 32 + r32) * 128;
#pragma unroll
            for (int hf = 0; hf < 2; ++hf)
#pragma unroll
                for (int j = 0; j < 2; ++j) { const int i0 = j * 16 + hi * 8;
                    f32x4 cs[2], sn[2]; cs[0] = *(const GAS f32x4*)(rt + hf * 64 + i0); cs[1] = *(const GAS f32x4*)(rt + hf * 64 + i0 + 4); sn[0] = *(const GAS f32x4*)(rt + hf * 64 + 32 + i0); sn[1] = *(const GAS f32x4*)(rt + hf * 64 + 32 + i0 + 4);
                    const v4u x1 = q[hf * 4 + j], x2 = q[hf * 4 + j + 2];
                    q[hf * 4 + j] = rope8(x1, x2, true, cs, sn); q[hf * 4 + j + 2] = rope8(x2, x1, false, cs, sn); } }
#pragma unroll
        for (int d0 = 0; d0 < 8; ++d0) qr[d0] = __builtin_bit_cast(bf16x8, q[d0]);
    }
    const float sink_raw = a->in[13][l * NHEAD + head] * (1.f / QK_SCALE);
    float m_reg = sink_raw, l_reg = 1.f; f32x16 o[4] = {};
    const int sr = tid >> 4, sc = (tid & 15) * 8, vst0 = v_st(sr, sc), vst1 = v_st(32 + sr, sc), vb0 = (int)(uintptr_t)Vl + v_rd_base(lane);
    const size_t cbase = LATENT ? (((size_t)b * DEPTH + l) * HKV + hkv) * PAST * HD : 0;
    auto tile_of = [&](int ti) -> AttnTile { AttnTile T;
        if (LATENT && ti < nt_win) { const int tok = tok_lo + ti * 64; T.kp = P + (size_t)(MP + b * SEQ_S + tok) * DIN + C_KA + hkv * HD; T.vp = P + (size_t)(MP + b * SEQ_S + tok) * DIN + C_VA + hkv * HD; T.stride = DIN; T.tok = tok; }
        else if (LATENT) { const int j = ti - nt_win; T.kp = (const bf16*)(a->ws + WS_CKB) + cbase + (size_t)j * 64 * HD; T.vp = (const bf16*)(a->ws + WS_CVB) + cbase + (size_t)j * 64 * HD; T.stride = HD; T.tok = -1; }
        else { T.kp = P + (size_t)(row0 + ti * 64) * DIN + C_KA + hkv * HD; T.vp = P + (size_t)(row0 + ti * 64) * DIN + C_VA + hkv * HD; T.stride = DIN; T.tok = -1; }
        return T; };
    v4u kA, kB, vA, vB;
    { const AttnTile T = tile_of(0); kA = *(const GAS v4u*)(T.kp + (size_t)sr * T.stride + sc); kB = *(const GAS v4u*)(T.kp + (size_t)(32 + sr) * T.stride + sc);
        vA = *(const GAS v4u*)(T.vp + (size_t)sr * T.stride + sc); vB = *(const GAS v4u*)(T.vp + (size_t)(32 + sr) * T.stride + sc); }
    for (int ti = 0; ti < NT; ++ti) {
        const AttnTile T = tile_of(ti);
        __syncthreads();
        if (LATENT && T.tok >= 0) {
            const bool first = ((sc >> 5) & 1) == 0; const int hf = sc >> 6, i0 = sc & 31;
            v4u pA, pB; pA.x = shxu(kA.x, 4, lane); pA.y = shxu(kA.y, 4, lane); pA.z = shxu(kA.z, 4, lane); pA.w = shxu(kA.w, 4, lane);
            pB.x = shxu(kB.x, 4, lane); pB.y = shxu(kB.y, 4, lane); pB.z = shxu(kB.z, 4, lane); pB.w = shxu(kB.w, 4, lane);
            { const float* rt = rope + (size_t)(T.tok + sr) * 128 + hf * 64 + i0; f32x4 cs[2], sn[2]; cs[0] = *(const GAS f32x4*)rt; cs[1] = *(const GAS f32x4*)(rt + 4); sn[0] = *(const GAS f32x4*)(rt + 32); sn[1] = *(const GAS f32x4*)(rt + 36); kA = rope8(kA, pA, first, cs, sn); }
            { const float* rt = rope + (size_t)(T.tok + 32 + sr) * 128 + hf * 64 + i0; f32x4 cs[2], sn[2]; cs[0] = *(const GAS f32x4*)rt; cs[1] = *(const GAS f32x4*)(rt + 4); sn[0] = *(const GAS f32x4*)(rt + 32); sn[1] = *(const GAS f32x4*)(rt + 36); kB = rope8(kB, pB, first, cs, sn); }
        }
        *(LAS v4u*)(Vl + vst0) = vA; *(LAS v4u*)(Vl + vst1) = vB;
        *(LAS v4u*)(Kl + KSWZ(sr, sc * 2)) = kA; *(LAS v4u*)(Kl + KSWZ(32 + sr, sc * 2)) = kB;
        if (ti + 1 < NT) { const AttnTile N = tile_of(ti + 1); kA = *(const GAS v4u*)(N.kp + (size_t)sr * N.stride + sc); kB = *(const GAS v4u*)(N.kp + (size_t)(32 + sr) * N.stride + sc);
            vA = *(const GAS v4u*)(N.vp + (size_t)sr * N.stride + sc); vB = *(const GAS v4u*)(N.vp + (size_t)(32 + sr) * N.stride + sc); }
        __syncthreads();
        bool skip = false, domask = false; const int qlo = t0 + wid * 32;
        if (LATENT && T.tok >= 0) { skip = (T.tok > qlo + 31 + 128) || (T.tok + 63 < qlo - 128); domask = !((T.tok >= qlo + 31 - 128) && (T.tok + 63 <= qlo + 128)); }
        if (!skip) {
            f32x16 p0, p1; float alpha; bf16x8 pa0, pa1, pa2, pa3;
            SBAR(); qkt(p0, p1, Kl, qr, r32, hi); SBAR();
            if (domask) { const int qt = qlo + r32;
#pragma unroll
                for (int r = 0; r < 16; ++r) { const int k0 = T.tok + crow(r, hi), d0 = k0 - qt, d1 = d0 + 32;
                    if (d0 > 128 || d0 < -128) p0[r] = -1e30f; if (d1 > 128 || d1 < -128) p1[r] = -1e30f; } }
            partialSM(p0, p1, m_reg, alpha);
            if (__any(alpha < 1.f)) { if (hi == 0) wsc[r32] = alpha; asm volatile("s_waitcnt lgkmcnt(0)" ::: "memory");
#pragma unroll
                for (int d = 0; d < 4; ++d)
#pragma unroll
                    for (int r = 0; r < 16; ++r) o[d][r] *= wsc[crow(r, hi)]; }
            finishSM(p0, p1, alpha, l_reg, pa0, pa1, pa2, pa3); SBAR();
            pv_one<0>(o[0], vb0, pa0, pa1, pa2, pa3); pv_one<1>(o[1], vb0, pa0, pa1, pa2, pa3); pv_one<2>(o[2], vb0, pa0, pa1, pa2, pa3); pv_one<3>(o[3], vb0, pa0, pa1, pa2, pa3);
        }
    }
    asm volatile("s_waitcnt lgkmcnt(0)" ::: "memory");
    if (hi == 0) wsc[32 + r32] = l_reg; asm volatile("s_waitcnt lgkmcnt(0)" ::: "memory");
    bf16* Ow = MIX + (size_t)(row0 + wid * 32) * DM + 1024 + head * HD + r32;
#pragma unroll
    for (int r = 0; r < 16; ++r) { const int orow = crow(r, hi); const float rl = __builtin_amdgcn_rcpf(wsc[32 + orow]);
#pragma unroll
        for (int d0 = 0; d0 < 4; ++d0) Ow[(size_t)orow * DM + d0 * 32] = (bf16)f2bf(o[d0][r] * rl); }
}
__device__ __forceinline__ void phase_attn(ArgP a, LAS unsigned char* lds, int l) {
    a = launder(a); const Ids I = make_ids();
    const int vcu = (I.G % 8 == 0) ? (I.bx % 8) * (I.G / 8) + I.bx / 8 : I.bx;
    for (int s = vcu; s < 256; s += I.G) {
        if (s < 128) attn_unit<true>(a, lds, l, s, I.tid);
        else {
#pragma unroll 1
            for (int k = 0; k < 2; ++k) attn_unit<false>(a, lds, l, 2 * (s - 128) + k, I.tid); }
    }
    __syncthreads();
}


constexpr size_t SRET_S_OFF = 0, SRET_P_OFF = (size_t)NB_S * NHEAD * 2 * 8 * HD * HD * 2;
template <int KS> __device__ __forceinline__ void kv_step(f32x16 (&acc)[2], int kb, int vb) {
    const s16x4 al = tr_read<v_rd_off(0, KS, 0)>(kb), ah = tr_read<v_rd_off(0, KS, 1)>(kb);
    const s16x4 b0l = tr_read<v_rd_off(0, KS, 0)>(vb), b0h = tr_read<v_rd_off(0, KS, 1)>(vb), b1l = tr_read<v_rd_off(1, KS, 0)>(vb), b1h = tr_read<v_rd_off(1, KS, 1)>(vb);
    asm volatile("s_waitcnt lgkmcnt(0)" ::: "memory"); SBAR();
    acc[0] = __builtin_amdgcn_mfma_f32_32x32x16_bf16(PKLH(al, ah), PKLH(b0l, b0h), acc[0], 0, 0, 0);
    acc[1] = __builtin_amdgcn_mfma_f32_32x32x16_bf16(PKLH(al, ah), PKLH(b1l, b1h), acc[1], 0, 0, 0);
}
__device__ __forceinline__ void ret_state_unit(ArgP a, LAS unsigned char* lds, int l, int unit, bool sample, int tid) {
    asm volatile("" : "+v"(tid));
    const int lane = tid & 63, wid = __builtin_amdgcn_readfirstlane(tid >> 6), r32 = lane & 31, hi = lane >> 5;
    const int b = unit >> 4, h = (unit >> 1) & 7, dir = unit & 1;
    const bf16* P = (const bf16*)(a->ws + WS_PROJ);
    const int N = sample ? 8 : 2, rowbase = sample ? MP + b * SEQ_S : b * SEQ_P;
    const float lg2 = a->in[11][(l * 2 + dir) * NHEAD + h] * LOG2E, cdec = exp2f(lg2 * 128.f);
    const int wa = wid >> 1, wb = (wid & 1) * 2;
    f32x16 acc[2];
    if (sample) { const float* s0 = a->in[4] + ((((size_t)b * DEPTH + l) * 2 + dir) * NHEAD + h) * HD * HD;
#pragma unroll
        for (int n = 0; n < 2; ++n)
#pragma unroll
            for (int r = 0; r < 16; ++r) acc[n][r] = s0[(size_t)(32 * wa + crow(r, hi)) * HD + 32 * (wb + n) + r32]; }
    else { acc[0] = (f32x16){}; acc[1] = (f32x16){}; }
    const int sr = tid >> 4, sc = (tid & 15) * 8;
    const int kb = (int)(uintptr_t)lds + v_rd_base(lane) + wa * 512, vb = (int)(uintptr_t)lds + 32768 + v_rd_base(lane) + wb * 512;
    unsigned char* sret = a->ws + WS_SRET + (sample ? SRET_S_OFF + (size_t)((b * NHEAD + h) * 2 + dir) * 8 * HD * HD * 2 : SRET_P_OFF + (size_t)((b * NHEAD + h) * 2 + dir) * HD * HD * 2);
    const int nsteps = sample ? 8 : 2;
    const bf16* kp0 = P + (size_t)rowbase * DIN + C_KR + h * HD + sc; const bf16* vp0 = P + (size_t)rowbase * DIN + C_VR + h * HD + sc;
    v4u kk[4], vv[4];
    { const int n0 = dir ? N - 1 : 0;
#pragma unroll
        for (int j = 0; j < 4; ++j) { kk[j] = *(const GAS v4u*)(kp0 + (size_t)(n0 * 128 + sr + 32 * j) * DIN); vv[j] = *(const GAS v4u*)(vp0 + (size_t)(n0 * 128 + sr + 32 * j) * DIN); } }
    for (int i = 0; i < nsteps; ++i) {
        const int n = dir ? N - 1 - i : i;
        if (sample || i == 1) { bf16* St = (bf16*)(sret + (sample ? (size_t)n * HD * HD * 2 : 0));
#pragma unroll
            for (int nn = 0; nn < 2; ++nn)
#pragma unroll
                for (int g = 0; g < 4; g += 2) {
                    unsigned ax = cvtpk(acc[nn][4 * g], acc[nn][4 * g + 1]), ay = cvtpk(acc[nn][4 * g + 2], acc[nn][4 * g + 3]);
                    unsigned bx = cvtpk(acc[nn][4 * g + 4], acc[nn][4 * g + 5]), by = cvtpk(acc[nn][4 * g + 6], acc[nn][4 * g + 7]);
                    const auto rx = __builtin_amdgcn_permlane32_swap(ax, bx, false, false), ry = __builtin_amdgcn_permlane32_swap(ay, by, false, false);
                    v4u w; w.x = rx[0]; w.y = ry[0]; w.z = rx[1]; w.w = ry[1];
                    *(GAS v4u*)(St + (size_t)(32 * (wb + nn) + r32) * HD + 32 * wa + 8 * g + 8 * hi) = w; } }
        if (sample && i == nsteps - 1) break;
        __syncthreads();
#pragma unroll
        for (int j = 0; j < 4; ++j) { const int c = sr + 32 * j; const float sc_ = QK_SCALE * __builtin_amdgcn_exp2f(lg2 * (float)(dir ? c : 127 - c));
            float f[8]; unpack8(kk[j], f); v4u w; w.x = pk2(f[0] * sc_, f[1] * sc_); w.y = pk2(f[2] * sc_, f[3] * sc_); w.z = pk2(f[4] * sc_, f[5] * sc_); w.w = pk2(f[6] * sc_, f[7] * sc_);
            *(LAS v4u*)(lds + (c >> 6) * 16384 + v_st(c & 63, sc)) = w; *(LAS v4u*)(lds + 32768 + (c >> 6) * 16384 + v_st(c & 63, sc)) = vv[j]; }
        { const int i2 = i + 1 < nsteps ? i + 1 : i, n2 = dir ? N - 1 - i2 : i2;
#pragma unroll
            for (int j = 0; j < 4; ++j) { kk[j] = *(const GAS v4u*)(kp0 + (size_t)(n2 * 128 + sr + 32 * j) * DIN); vv[j] = *(const GAS v4u*)(vp0 + (size_t)(n2 * 128 + sr + 32 * j) * DIN); } }
        __syncthreads();
#pragma unroll
        for (int r = 0; r < 16; ++r) { acc[0][r] *= cdec; acc[1][r] *= cdec; }
        kv_step<0>(acc, kb, vb); kv_step<1>(acc, kb, vb); kv_step<2>(acc, kb, vb); kv_step<3>(acc, kb, vb);
        kv_step<0>(acc, kb + 16384, vb + 16384); kv_step<1>(acc, kb + 16384, vb + 16384); kv_step<2>(acc, kb + 16384, vb + 16384); kv_step<3>(acc, kb + 16384, vb + 16384);
    }
    if (!sample) { float* out = a->out + OUT_ST + ((((size_t)b * DEPTH + l) * 2 + dir) * NHEAD + h) * HD * HD;
#pragma unroll
        for (int n = 0; n < 2; ++n)
#pragma unroll
            for (int r = 0; r < 16; ++r) __builtin_nontemporal_store(acc[n][r], out + (size_t)(32 * wa + crow(r, hi)) * HD + 32 * (wb + n) + r32); }
    __syncthreads();
}

__device__ __forceinline__ void cross_term(f32x16& od, LAS const unsigned char* St, int d0, const bf16x8 (&qr)[8], int r32, int hi, float lg2, int cq0, bool fwd) {
    f32x16 acc = (f32x16){};
#pragma unroll
    for (int ks = 0; ks < 8; ++ks) { const bf16x8 bfrag = *(LAS const bf16x8*)(St + KSWZ(32 * d0 + r32, (ks * 16 + hi * 8) * 2)); acc = __builtin_amdgcn_mfma_f32_32x32x16_bf16(qr[ks], bfrag, acc, 0, 0, 0); }
#pragma unroll
    for (int r = 0; r < 16; ++r) { const int cq = cq0 + crow(r, hi); od[r] += acc[r] * __builtin_amdgcn_exp2f(lg2 * (float)(fwd ? cq + 1 : 128 - cq)); }
}
struct RetPre { v4u kk[4], vv[4], sf[4], sb[4]; };
struct RetUnit { int ch, h, rowbase, b, n; bool sample, has_f, has_b; };
__device__ __forceinline__ RetUnit ret_unit_of(int unit) { RetUnit U; U.ch = unit >> 3; U.h = unit & 7; U.rowbase = U.ch * 128; U.sample = U.ch >= 64;
    U.b = U.sample ? (U.ch - 64) >> 3 : U.ch >> 1; U.n = U.sample ? (U.ch - 64) & 7 : U.ch & 1; U.has_f = U.sample || U.n == 1; U.has_b = U.sample || U.n == 0; return U; }
__device__ __forceinline__ void ret_out_load(ArgP a, const RetUnit& U, RetPre& R, int tid) {
    asm volatile("" : "+v"(tid));
    const int sr = tid >> 4, sc = (tid & 15) * 8;
    const bf16* P = (const bf16*)(a->ws + WS_PROJ); const unsigned char* sbase = a->ws + WS_SRET;
    const bf16* Sf = (const bf16*)(sbase + (U.sample ? SRET_S_OFF + ((size_t)(((U.b * NHEAD + U.h) * 2 + 0) * 8 + U.n)) * HD * HD * 2 : SRET_P_OFF + (size_t)((U.b * NHEAD + U.h) * 2 + 0) * HD * HD * 2));
    const bf16* Sb = (const bf16*)(sbase + (U.sample ? SRET_S_OFF + ((size_t)(((U.b * NHEAD + U.h) * 2 + 1) * 8 + U.n)) * HD * HD * 2 : SRET_P_OFF + (size_t)((U.b * NHEAD + U.h) * 2 + 1) * HD * HD * 2));
    const bf16* kp = P + (size_t)U.rowbase * DIN + C_KR + U.h * HD + sc; const bf16* vp = P + (size_t)U.rowbase * DIN + C_VR + U.h * HD + sc;
#pragma unroll
    for (int j = 0; j < 4; ++j) { R.kk[j] = *(const GAS v4u*)(kp + (size_t)(sr + 32 * j) * DIN); R.vv[j] = *(const GAS v4u*)(vp + (size_t)(sr + 32 * j) * DIN); }
#pragma unroll
    for (int j = 0; j < 4; ++j) { R.sf[j] = U.has_f ? *(const GAS v4u*)(Sf + (size_t)(sr + 32 * j) * HD + sc) : (v4u){0u, 0u, 0u, 0u}; R.sb[j] = U.has_b ? *(const GAS v4u*)(Sb + (size_t)(sr + 32 * j) * HD + sc) : (v4u){0u, 0u, 0u, 0u}; }
}
__device__ __forceinline__ void phase_mix2(ArgP a, LAS unsigned char* lds, int l) {
    a = launder(a); const Ids I = make_ids();
    const int vcu = (I.G % 8 == 0) ? (I.bx % 8) * (I.G / 8) + I.bx / 8 : I.bx;
    constexpr int NU = 96 * NHEAD;
    RetPre R;
#define LBAR() do { asm volatile("s_waitcnt lgkmcnt(0)" ::: "memory"); __builtin_amdgcn_s_barrier(); asm volatile("" ::: "memory"); } while (0)
    int tab_h = -1; LAS float* gnt = (LAS float*)(lds + EX_OFF);
    int u = vcu;
    if (u < NU) { const RetUnit U0 = ret_unit_of(u); ret_out_load(a, U0, R, I.tid); }
#pragma unroll 1
    for (; u < NU; u += I.G) {
        int tid = I.tid; asm volatile("" : "+v"(tid));
        const int lane = tid & 63, wid = __builtin_amdgcn_readfirstlane(tid >> 6), r32 = lane & 31, hi = lane >> 5;
        const int sr = tid >> 4, sc = (tid & 15) * 8, wq = wid & 3, wd = wid >> 2;
        const bf16* P = (const bf16*)(a->ws + WS_PROJ); bf16* MIX = (bf16*)(a->ws + WS_MIX);
        LAS unsigned char* Kt = lds; LAS unsigned char* Vi = lds + 32768; LAS unsigned char* Stf = lds + 65536; LAS unsigned char* Stb = lds + 98304;
        const RetUnit U = ret_unit_of(u);
        const float lgf2 = a->in[11][(l * 2 + 0) * NHEAD + U.h] * LOG2E, lgb2 = a->in[11][(l * 2 + 1) * NHEAD + U.h] * LOG2E;
        LBAR();
        if (U.h != tab_h) { tab_h = U.h; if (tid < HD) gnt[tid] = a->in[12][l * 1024 + U.h * HD + tid]; }
#pragma unroll
        for (int j = 0; j < 4; ++j) { const int c = sr + 32 * j; *(LAS v4u*)(Kt + KSWZ(c, sc * 2)) = R.kk[j]; *(LAS v4u*)(Vi + (c >> 6) * 16384 + v_st(c & 63, sc)) = R.vv[j];
            *(LAS v4u*)(Stf + KSWZ(c, sc * 2)) = R.sf[j]; *(LAS v4u*)(Stb + KSWZ(c, sc * 2)) = R.sb[j]; }
        bf16x8 qr[8];
        { const bf16* Qw = P + (size_t)(U.rowbase + wq * 32 + r32) * DIN + C_QR + U.h * HD + hi * 8;
#pragma unroll
            for (int d0 = 0; d0 < 8; ++d0) qr[d0] = __builtin_bit_cast(bf16x8, *(const GAS v4u*)(Qw + d0 * 16)); }
        const int erow = tid >> 2, eqd = tid & 3;
        v4u gw[4];
        { const bf16* gp = P + (size_t)(U.rowbase + erow) * DIN + C_GR + U.h * HD + 32 * eqd;
#pragma unroll
            for (int j = 0; j < 4; ++j) gw[j] = *(const GAS v4u*)(gp + 8 * j); }
        LBAR();
        f32x16 p0, p1, p2, p3;
        SBAR(); qkt(p0, p1, Kt, qr, r32, hi); SBAR(); qkt(p2, p3, Kt + 16384, qr, r32, hi); SBAR();
        { const int c = wq * 32 + r32;
#define DECAY(PX, KB) _Pragma("unroll") for (int r = 0; r < 16; ++r) { const int d = c - ((KB) * 32 + crow(r, hi)); \
            const float ex = __builtin_amdgcn_exp2f((d > 0 ? lgf2 : -lgb2) * (float)d); PX[r] *= (d == 0 ? 2.f * QK_SCALE : ex * QK_SCALE); }
            DECAY(p0, 0) DECAY(p1, 1) DECAY(p2, 2) DECAY(p3, 3)
#undef DECAY
        }
        bf16x8 pa0, pa1, pa2, pa3, pb0, pb1, pb2, pb3;
        pack_p(p0, p1, pa0, pa1, pa2, pa3); pack_p(p2, p3, pb0, pb1, pb2, pb3); SBAR();
        f32x16 od[2] = {};
        const int cq0 = wq * 32;
        if (U.has_f) { cross_term(od[0], Stf, 2 * wd, qr, r32, hi, lgf2, cq0, true); SBAR(); cross_term(od[1], Stf, 2 * wd + 1, qr, r32, hi, lgf2, cq0, true); SBAR(); }
        if (U.has_b) { cross_term(od[0], Stb, 2 * wd, qr, r32, hi, lgb2, cq0, false); SBAR(); cross_term(od[1], Stb, 2 * wd + 1, qr, r32, hi, lgb2, cq0, false); SBAR(); }
        const int vb = (int)(uintptr_t)Vi + v_rd_base(lane) + wd * 1024;
        pv_one<0>(od[0], vb, pa0, pa1, pa2, pa3); pv_one<1>(od[1], vb, pa0, pa1, pa2, pa3);
        pv_one<0>(od[0], vb + 16384, pb0, pb1, pb2, pb3); pv_one<1>(od[1], vb + 16384, pb0, pb1, pb2, pb3);
        LBAR();
        LAS float* Os = (LAS float*)lds;
#pragma unroll
        for (int dd = 0; dd < 2; ++dd)
#pragma unroll
            for (int r = 0; r < 16; ++r) Os[(wq * 32 + crow(r, hi)) * 132 + 32 * (2 * wd + dd) + r32] = od[dd][r];
        LBAR();
        { const RetUnit UN = ret_unit_of(u + I.G < NU ? u + I.G : u); ret_out_load(a, UN, R, tid); }
        { const LAS float* op = Os + erow * 132 + 32 * eqd;
            f32x4 v[8]; float s = 0.f;
#pragma unroll
            for (int j = 0; j < 8; ++j) { v[j] = *(const LAS f32x4*)(op + 4 * j); s += (v[j].x + v[j].y) + (v[j].z + v[j].w); }
            s += shx(s, 1, lane); s += shx(s, 2, lane);
            const float mu = s * (1.f / HD); float q = 0.f;
#pragma unroll
            for (int j = 0; j < 8; ++j) { v[j] = v[j] - mu; q += (v[j].x * v[j].x + v[j].y * v[j].y) + (v[j].z * v[j].z + v[j].w * v[j].w); }
            q += shx(q, 1, lane); q += shx(q, 2, lane);
            const float rs = 1.f / sqrtf(q * (1.f / HD) + EPS);
            const LAS float* gn = gnt + 32 * eqd;
            bf16* op2 = MIX + (size_t)(U.rowbase + erow) * DM + U.h * HD + 32 * eqd;
#pragma unroll
            for (int j = 0; j < 4; ++j) { float g[8]; unpack8(gw[j], g);
                const f32x4 n0 = *(const LAS f32x4*)(gn + 8 * j), n1 = *(const LAS f32x4*)(gn + 8 * j + 4);
                float y[8];
#pragma unroll
                for (int e = 0; e < 4; ++e) { y[e] = silu_f(g[e]) * (v[2 * j][e] * rs * n0[e]); y[4 + e] = silu_f(g[4 + e]) * (v[2 * j + 1][e] * rs * n1[e]); }
                v4u w; w.x = pk2(y[0], y[1]); w.y = pk2(y[2], y[3]); w.z = pk2(y[4], y[5]); w.w = pk2(y[6], y[7]);
                *(GAS v4u*)(op2 + 8 * j) = w; }
        }
    }
    __syncthreads();
#undef LBAR
}
__device__ __forceinline__ void phase_mix1(ArgP a, LAS unsigned char* lds, int l) {
    a = launder(a); const Ids I = make_ids();
    const int vcu = (I.G % 8 == 0) ? (I.bx % 8) * (I.G / 8) + I.bx / 8 : I.bx;
    for (int s = vcu; s < 256; s += I.G) {
        int pu0, npu, su;
        if (s < 128) { attn_unit<true>(a, lds, l, s, I.tid); pu0 = 3 * s; npu = 3; su = -1; }
        else {
            if (s >= 224) {
                unsigned char* ws = a->ws; const int j = s - 224;
                pg8::Gemm g{(const pg8::bf16_t*)(ws + WS_H), (const pg8::bf16_t*)(ws + WS_WIN) + (size_t)l * DIN * DM, MTOK, DIN, DM};
                pg8::OneUnit S; S.u.pm = 40 + (j & 7); S.u.pn = j >> 3; S.u.half = 0; S.u.h = 0; S.u.part = 0; S.u.slab = 0;
                pg8::EpiIn E{(pg8::bf16_t*)(ws + WS_PROJ), a->out + OUT_CK, a->out + OUT_CV, l, (const float*)(ws + WS_RSS1), (const float*)(ws + WS_SWIN) + (size_t)l * NCOND * DIN};
                pg8::gemm_phase<pg8::EpiIn, pg8::OneUnit, true, true>(lds, g, S, E);
                __syncthreads();
            }
#pragma unroll 1
            for (int k = 0; k < 2; ++k) attn_unit<false>(a, lds, l, 2 * (s - 128) + k, I.tid);
            if (s < 192) { pu0 = 0; npu = 0; su = s - 128; } else if (s < 224) { pu0 = 384 + 4 * (s - 192); npu = 4; su = -1; } else { pu0 = 0; npu = 0; su = -1; }
        }
        __syncthreads();
#pragma unroll 1
        for (int k = (su >= 0 ? -1 : 0); k < npu; ++k) ret_state_unit(a, lds, l, k < 0 ? su : pu0 + k, k < 0, I.tid);
    }
}

__device__ __forceinline__ void filler_convert(ArgP a, LAS unsigned char* lds, int slot) {
    a = launder(a); const Ids I = make_ids();
    const bool all = I.G != 256 || (slot & 1) == 0;
    const int tk = all ? 0 : __builtin_amdgcn_readfirstlane((int)*(LAS const unsigned*)(lds + TK_SLOT));
    if (!(all || tk >= 64)) return;
    const int wi = all ? I.gw : (tk - 64) * 8 + I.wave, nw = all ? I.NGW : 192 * 8;
    constexpr int FSPLIT = 3072;
    convert_weights(a, lds, 1 + (slot >> 1), (slot & 1) ? FSPLIT : 0, (slot & 1) ? I_LAYER : FSPLIT, wi, nw, I.tid);
}
constexpr int NPH_L = 7, PH_FINAL = 3 + DEPTH * NPH_L, NPHASES = PH_FINAL + 1;
__global__ void __launch_bounds__(NWAVES * 64, 2) fwd(Args args) {
    extern __shared__ __attribute__((aligned(16))) unsigned char lds_raw[];
    LAS unsigned char* lds = (LAS unsigned char*)lds_raw;
    ArgP argp = (ArgP)__builtin_amdgcn_kernarg_segment_ptr();
    volatile LAS unsigned* MISC = (volatile LAS unsigned*)(lds + MISC_OFF);
    for (int u = threadIdx.x; u < (LDS_BYTES - 131072) / 4; u += NWAVES * 64) ((LAS unsigned*)(lds + 131072))[u] = 0u;
    __syncthreads();
    tid_publish(threadIdx.x);
    __syncthreads();
    XcdBarrier bar; bar.bar = (unsigned*)(argp->ws + WS_CTL) + CW_BAR; bar.x = 0; bar.st = nullptr;
    bar = xcd_barrier_post((unsigned*)(argp->ws + WS_CTL) + CW_BAR, MISC + 8);
#ifndef PHMASK
#define PHMASK 0xFFFFFFFFu
#endif
#define PHON(b) ((PHMASK >> (b)) & 1u)
#ifndef DUPMASK
#define DUPMASK 0u
#endif
#define DUPON(b) ((DUPMASK >> (b)) & 1u)
#define REP(b) _Pragma("unroll 1") for (int rep_ = 0; rep_ < (DUPON(b) ? 2 : 1); ++rep_)
#define IN(k) true
#ifndef SEAMREP
#define SEAMREP 1
#endif
#define SEAM(k) do { _Pragma("unroll 1") for (int sr_ = 0; sr_ < SEAMREP; ++sr_) xcd_barrier(bar); } while (0)
#define GEMM_SETUP() ArgP ap = launder(argp); unsigned char* ws = ap->ws; int bx = blockIdx.x, G = gridDim.x; asm volatile("" : "+s"(bx), "+s"(G))
    if (PHON(0) && IN(0)) { REP(0) phase_prologue_a(argp, lds); SEAM(0); }
    if (PHON(1) && IN(1)) { REP(1) phase_prologue_b(argp); SEAM(1); }
    if (PHON(2) && IN(2)) { REP(2) phase_prologue_c(argp, lds); SEAM(2); }
    for (int l = 0; l < DEPTH; ++l) {
        const int pb = 3 + l * NPH_L;
        if (PHON(3) && IN(pb + 0)) {
            GEMM_SETUP();
            { const Ids I = make_ids(); zero_f32((float*)(ws + WS_RSS2), MTOK, I.gt, I.NGT); }
            pg8::Gemm g{(const pg8::bf16_t*)(ws + WS_H), (const pg8::bf16_t*)(ws + WS_WIN) + (size_t)l * DIN * DM, MTOK, DIN, DM}; pg8::InMainOrder S; S.init(G, bx);
            pg8::EpiIn E{(pg8::bf16_t*)(ws + WS_PROJ), ap->out + OUT_CK, ap->out + OUT_CV, l, (const float*)(ws + WS_RSS1), (const float*)(ws + WS_SWIN) + (size_t)l * NCOND * DIN};
            REP(3) pg8::gemm_phase<pg8::EpiIn, pg8::InMainOrder, true, true>(lds, g, S, E);
            if (l < 3) filler_convert(argp, lds, 2 * l);
            SEAM(pb + 0);
        }
        if (PHON(4) && IN(pb + 1)) { REP(4) phase_mix1(argp, lds, l); SEAM(pb + 1); }
        if (PHON(5) && IN(pb + 2)) { REP(5) phase_mix2(argp, lds, l); SEAM(pb + 2); }
        if (PHON(6) && IN(pb + 3)) {
            GEMM_SETUP();
            pg8::Gemm g{(const pg8::bf16_t*)(ws + WS_MIX), (const pg8::bf16_t*)(ws + WS_WOUT) + (size_t)l * DM * DM, MTOK, DM, DM}; pg8::TailOrderK S; S.init2(MTOK, DM, G, bx, 256, (float*)(ws + WS_SLAB), (unsigned*)(ws + WS_CTL) + CW_KS, 1u + 2u * (unsigned)l);
            const float* modl = (const float*)(ws + WS_MOD) + (size_t)l * NCOND * NMODC;
            pg8::EpiRes E{l == 0 ? ap->in[0] : (const float*)(ws + WS_X), l == 0 ? ap->in[1] : (const float*)(ws + WS_X) + (size_t)MP * DM, (float*)(ws + WS_X), modl + 2 * DM, modl + 4 * DM, (pg8::bf16_t*)(ws + WS_H), (float*)(ws + WS_RSS2), 0, (const float*)(ws + WS_SLAB)};
            REP(6) { E.dry = (DUPON(6) && rep_ == 0); pg8::gemm_phase<pg8::EpiRes, pg8::TailOrderK, true, true>(lds, g, S, E); }
            SEAM(pb + 3);
        }
        if (PHON(8) && IN(pb + 4)) {
            GEMM_SETUP();
            { const Ids I = make_ids(); zero_f32((float*)(ws + WS_RSS1), MTOK, I.gt, I.NGT); }
            pg8::Gemm g{(const pg8::bf16_t*)(ws + WS_H), (const pg8::bf16_t*)(ws + WS_WUP) + (size_t)l * DUP * DM, MTOK, DUP, DM}; pg8::TailOrderDyn S; S.init2(MTOK, DUP, G, bx, 2048, (unsigned*)(ws + WS_CTL) + CW_TK + 16 * l, (PG8_LAS unsigned*)(lds + TK_SLOT));
            pg8::EpiUpConv E{(pg8::bf16_t*)(ws + WS_ACT), (const float*)(ws + WS_RSS2), (const float*)(ws + WS_SWUP) + (size_t)l * NCOND * DUP, ap->in[15] + (size_t)l * 3 * DUP, ap->in[16] + (size_t)l * DUP, (float*)(ws + WS_HALO), (PG8_LAS float*)(lds + EX_OFF)};
            REP(8) pg8::gemm_phase<pg8::EpiUpConv, pg8::TailOrderDyn, true, true>(lds, g, S, E);
            if (l < 3) filler_convert(argp, lds, 2 * l + 1);
            SEAM(pb + 4);
        }
        if (PHON(9) && IN(pb + 5)) { REP(9) phase_convfix(argp, l); SEAM(pb + 5); }
        if (PHON(10) && IN(pb + 6)) {
            GEMM_SETUP();
            pg8::Gemm g{(const pg8::bf16_t*)(ws + WS_ACT), (const pg8::bf16_t*)(ws + WS_WDN) + (size_t)l * DM * DFF, MTOK, DM, DFF}; pg8::TailOrderK S; S.init2(MTOK, DM, G, bx, 256, (float*)(ws + WS_SLAB), (unsigned*)(ws + WS_CTL) + CW_KS, 2u + 2u * (unsigned)l);
            const float* modl = (const float*)(ws + WS_MOD) + (size_t)l * NCOND * NMODC;
            pg8::EpiRes E{(const float*)(ws + WS_X), (const float*)(ws + WS_X) + (size_t)MP * DM, (float*)(ws + WS_X), modl + 5 * DM, l + 1 < DEPTH ? modl + NCOND * NMODC + DM : nullptr, (pg8::bf16_t*)(ws + WS_H), (float*)(ws + WS_RSS1), 0, (const float*)(ws + WS_SLAB)};
            REP(10) { E.dry = (DUPON(10) && rep_ == 0); pg8::gemm_phase<pg8::EpiRes, pg8::TailOrderK, true, true>(lds, g, S, E); }
            SEAM(pb + 6);
        }
    }
    if (PHON(11) && IN(PH_FINAL)) { REP(11) phase_final(argp); }
#undef IN
#undef SEAM
}

#ifndef N_LAUNCH_MODE
#define N_LAUNCH_MODE 1
#endif
extern "C" void kernel_launch(void* const* d_in, const int* in_sizes, int n_in, void* d_out, int out_size, void* d_ws, size_t ws_size, hipStream_t stream) {
    static int grid = 0;
    if (grid == 0) {
        if (n_in != 19 || (size_t)out_size != OUT_TOTAL || ws_size < WS_END) { fprintf(stderr, "kernel_launch: shape mismatch: n_in %d out %d ws %zu (need %zu)\n", n_in, out_size, ws_size, (size_t)WS_END); grid = -1; return; }
        int dev = 0, cus = 0, per_cu = 0;
        if (hipGetDevice(&dev) != hipSuccess || hipDeviceGetAttribute(&cus, hipDeviceAttributeMultiprocessorCount, dev) != hipSuccess) { grid = -1; return; }
        if (hipFuncSetAttribute((const void*)fwd, hipFuncAttributeMaxDynamicSharedMemorySize, LDS_BYTES) != hipSuccess) { fprintf(stderr, "kernel_launch: hipFuncSetAttribute failed\n"); grid = -1; return; }
        if (hipOccupancyMaxActiveBlocksPerMultiprocessor(&per_cu, (const void*)fwd, NWAVES * 64, LDS_BYTES) != hipSuccess || per_cu < 1) fprintf(stderr, "kernel_launch: occupancy query says %d\n", per_cu);
        (void)hipGetLastError();
        grid = cus;
    }
    if (grid < 0) return;
    if (hipMemsetAsync((char*)d_ws + WS_CTL, 0, CTL_ZERO_BYTES, stream) != hipSuccess) return;
    Args a{};
    for (int i = 0; i < 19; ++i) a.in[i] = (const float*)d_in[i];
    a.out = (float*)d_out; a.ws = (unsigned char*)d_ws;
    a.ph_lo = 0; a.ph_hi = NPHASES;
    hipLaunchKernelGGL(fwd, dim3(grid), dim3(NWAVES * 64), LDS_BYTES, stream, a);
    const hipError_t le = hipPeekAtLastError();
    if (le != hipSuccess) fprintf(stderr, "kernel_launch: launch failed: %s\n", hipGetErrorName(le));
}
```

```cpp
#include <hip/hip_runtime.h>
#include <cstdio>
#include <cstdint>
#define WMAP_OFF 131584
__device__ __forceinline__ int tid_now() {
    const unsigned slot = (unsigned)__builtin_amdgcn_s_getreg((5 << 11) | 4) & 63u;
    const int w = __builtin_amdgcn_readfirstlane(*(const __attribute__((address_space(3))) int*)(unsigned long)(WMAP_OFF + 4 * slot));
    int ln; asm volatile("v_mbcnt_lo_u32_b32 %0, -1, 0\n\tv_mbcnt_hi_u32_b32 %0, -1, %0" : "=v"(ln));
    return w * 64 + ln;
}
__device__ __forceinline__ void tid_publish(int tid) {
    const unsigned slot = (unsigned)__builtin_amdgcn_s_getreg((5 << 11) | 4) & 63u;
    if ((tid & 63) == 0) *(__attribute__((address_space(3))) int*)(unsigned long)(WMAP_OFF + 4 * slot) = tid >> 6;
}
namespace pg8 {
#define PG8_LAS __attribute__((address_space(3)))
typedef unsigned short bf16_t;
typedef short bf16x8 __attribute__((ext_vector_type(8)));
typedef float f32x4 __attribute__((ext_vector_type(4)));
typedef unsigned u32x4 __attribute__((ext_vector_type(4)));
constexpr int BM = 256, BK = 64, HALF = 128, HTB = HALF * BK * 2  , STAGE_BYTES = 8 * HTB, NXCD = 8, WGM = 8;

__host__ __device__ __forceinline__ int lds_byte(int r, int c) { const int st = (r >> 4) * 2 + (c >> 5), rr = r & 15, cc = c & 31, ob = rr * 64 + cc * 2; return st * 1024 + (ob ^ (((ob >> 9) & 1) << 5)); }
__host__ __device__ __forceinline__ void stage_rc(int b, int& R, int& C) { const int st = b / 1024, sb = b % 1024, swz = sb ^ (((sb >> 9) & 1) << 5); R = (st >> 1) * 16 + swz / 64; C = (st & 1) * 32 + (swz % 64) / 2; }
__host__ __device__ __forceinline__ int perm32(int rho) { const int n = rho >> 4, i = rho & 15; return 8 * (i >> 2) + 4 * n + (i & 3); }

struct Unit { int pm, pn, half, h, part, slab; };
struct Gemm { const bf16_t* A; const bf16_t* Bt; int M, N, K; };

struct StaticOrder {
    static constexpr bool KSPLIT = false, DYN = false;
    int nM, nN, nwg, G, c;
    __host__ __device__ void init(int M, int N, int G_, int c_) { nM = M / BM; nN = N / BM; nwg = nM * nN; G = G_; c = c_; }
    __host__ __device__ bool next(int i, Unit& u) const { const long L = (long)i * G + c; if (L >= nwg) return false; tile((int)L, u); return true; }
    __host__ __device__ bool tile(int L, Unit& u) const {
        int wgid = L; { const int q = nwg / NXCD, r = nwg % NXCD, xcd = wgid % NXCD, off = wgid / NXCD; wgid = (xcd < r ? xcd * (q + 1) : r * (q + 1) + (xcd - r) * q) + off; }
        const int nig = WGM * nN, gid = wgid / nig, fm = gid * WGM, gsz = (nM - fm) < WGM ? (nM - fm) : WGM;
        u.pm = fm + ((wgid % nig) % gsz); u.pn = (wgid % nig) / gsz; u.half = 0; u.h = 0; u.part = 0; u.slab = 0; return true;
    }
    __device__ __forceinline__ void a_ready(const Unit&) const {}
    __device__ __forceinline__ void done(const Unit&) const {}
};
struct TailOrder : StaticOrder {
    int nfull;
    __device__ __forceinline__ void init2(int M, int N, int G_, int c_, int nfull_) { init(M, N, G_, c_); nfull = nfull_; }
    __device__ __forceinline__ bool next(int i, Unit& u) const {
        if (G != 256) return StaticOrder::next(i, u);
        const int nr = nfull >> 8;
        if (i < nr) { tile(i * 256 + c, u); return true; }
        const int x = c & 7, q = c >> 3, j = (q >> 1) * 8 + x;
        if (i > nr || nfull + j >= nwg) return false;
        tile(nfull + j, u); u.half = 1; u.h = q & 1; return true;
    }
};
struct TailOrderK : StaticOrder {
    static constexpr bool KSPLIT = true;
    int nfull; float* slab; unsigned* flags; unsigned epoch;
    __device__ __forceinline__ void init2(int M, int N, int G_, int c_, int nfull_, float* slab_, unsigned* flags_, unsigned epoch_) { init(M, N, G_, c_); nfull = nfull_; slab = slab_; flags = flags_; epoch = epoch_; }
    __device__ __forceinline__ bool next(int i, Unit& u) const {
        if (G != 256) return StaticOrder::next(i, u);
        const int nr = nfull >> 8;
        if (i < nr) { tile(i * 256 + c, u); return true; }
        const int x = c & 7, q = c >> 3, j = (q >> 1) * 8 + x;
        if (i > nr || nfull + j >= nwg) return false;
        tile(nfull + j, u); u.part = 1 + (q & 1); u.slab = j; return true;
    }
};
struct InMainOrder {
    static constexpr bool KSPLIT = false, DYN = false;
    int G, c;
    __device__ __forceinline__ void init(int G_, int c_) { G = G_; c = c_; }
    __device__ __forceinline__ bool next(int i, Unit& u) const {
        const int L = i * G + c; if (L >= 1024) return false;
        const int w = (G == 256) ? (c & 7) * 128 + i * 32 + (c >> 3) : L;
        if (w < 880) { const int r = w % 176; u.pm = (w / 176) * 8 + (r & 7); u.pn = r >> 3; } else { const int r = w - 880; u.pm = 40 + (r & 7); u.pn = 4 + (r >> 3); }
        u.half = 0; u.h = 0; u.part = 0; u.slab = 0; return true;
    }
    __device__ __forceinline__ void a_ready(const Unit&) const {}
    __device__ __forceinline__ void done(const Unit&) const {}
};
struct TailOrderDyn : StaticOrder {
    static constexpr bool DYN = true;
    int nfull; unsigned* ctr; PG8_LAS unsigned* slot;
    __device__ __forceinline__ void init2(int M, int N, int G_, int c_, int nfull_, unsigned* ctr_, PG8_LAS unsigned* slot_) { init(M, N, G_, c_); nfull = nfull_; ctr = ctr_; slot = slot_; }
    __device__ __forceinline__ void pre_epi(int ui, int tid) const {
        if (G != 256 || ui != (nfull >> 8) - 2) return;
        if (tid == 0) { const unsigned t = __hip_atomic_fetch_add(ctr, 1u, __ATOMIC_RELAXED, __HIP_MEMORY_SCOPE_AGENT); *slot = t; asm volatile("s_waitcnt lgkmcnt(0)" ::: "memory"); }
    }
    __device__ __forceinline__ bool next(int i, Unit& u) const {
        if (G != 256) return StaticOrder::next(i, u);
        const int nr = nfull >> 8;
        if (i < nr) { tile(i * 256 + c, u); return true; }
        if (i > nr) return false;
        const int t = __builtin_amdgcn_readfirstlane((int)*slot);
        if (nfull + t >= nwg) return false;
        tile(nfull + t, u); return true;
    }
};
struct OneUnit {
    static constexpr bool KSPLIT = false, DYN = false;
    Unit u;
    __device__ __forceinline__ bool next(int i, Unit& o) const { if (i != 0) return false; o = u; return true; }
    __device__ __forceinline__ void a_ready(const Unit&) const {}
    __device__ __forceinline__ void done(const Unit&) const {}
};
__device__ __forceinline__ unsigned cvt_pk_bf16(float lo, float hi) { unsigned r; asm volatile("v_cvt_pk_bf16_f32 %0, %1, %2" : "=v"(r) : "v"(lo), "v"(hi)); return r; }
template <class Epi, class Sched, bool ALIGN_EPI = false, bool SP2 = false>
__device__ __forceinline__ void gemm_phase(PG8_LAS unsigned char* lds, const Gemm g, const Sched& S, const Epi& E) {
    int tid_ = tid_now(); asm volatile("" : "+v"(tid_));
    const int tid = tid_, wid = __builtin_amdgcn_readfirstlane(tid >> 6), lane = tid & 63, wr = wid >> 2, wc = wid & 3, fr = lane & 15, fq = lane >> 4;
    const int K = g.K, nt = K / BK;
    unsigned voffA[2], voffB[2];
#pragma unroll
    for (int i = 0; i < 2; ++i) { int R, C; stage_rc(tid * 16 + i * 8192, R, C); const int Rb = Epi::PERM ? ((R & ~31) + perm32(R & 31)) : R;
        voffA[i] = (unsigned)(R * K + C) * 2u; voffB[i] = (unsigned)(Rb * K + C) * 2u; }
    const size_t kstep = (size_t)(BK * 2);
    const size_t hstep = (size_t)HALF * K * 2;
    const size_t tstep = 2 * hstep;
    const unsigned ldsw = (unsigned)wid * 1024u;
    const int aoff = lds_byte(wr * 64 + fr, fq * 8), boff = lds_byte(wc * 32 + fr, fq * 8);
#define PG8_SA(b, h) (((b) * 2 + (h)) * HTB)
#define PG8_SB(b, h) ((4 + (b) * 2 + (h)) * HTB)
#define PG8_STAGE(bufoff, gbase, voff) do { _Pragma("unroll") for (int _i = 0; _i < 2; ++_i) \
        __builtin_amdgcn_global_load_lds((const unsigned*)((const char*)(gbase) + (voff)[_i]), (PG8_LAS unsigned*)(lds + (bufoff) + ldsw + _i * 8192), 16, 0, 0); } while (0)
#define PG8_LDA(dst, b, h) do { _Pragma("unroll") for (int m = 0; m < 4; ++m) _Pragma("unroll") for (int k = 0; k < 2; ++k) dst[m][k] = *(const PG8_LAS bf16x8*)(lds + PG8_SA(b, h) + aoff + m * 2048 + k * 1024); } while (0)
#define PG8_LDB(dst, b, h) do { _Pragma("unroll") for (int n = 0; n < 2; ++n) _Pragma("unroll") for (int k = 0; k < 2; ++k) dst[n][k] = *(const PG8_LAS bf16x8*)(lds + PG8_SB(b, h) + boff + n * 2048 + k * 1024); } while (0)
#define PG8_MMA(ai, bj, At, Bt) do { __builtin_amdgcn_s_setprio(1); _Pragma("unroll") for (int m = 0; m < 4; ++m) _Pragma("unroll") for (int n = 0; n < 2; ++n) _Pragma("unroll") for (int k = 0; k < 2; ++k) \
        acc[ai][bj][m][n] = __builtin_amdgcn_mfma_f32_16x16x32_bf16(Bt[n][k], At[m][k], acc[ai][bj][m][n], 0, 0, 0); __builtin_amdgcn_s_setprio(0); } while (0)
#define PG8_WAIT_V(n) asm volatile("s_waitcnt vmcnt(" #n ")" ::: "memory")
#define PG8_WAIT_L(n) asm volatile("s_waitcnt lgkmcnt(" #n ")" ::: "memory")
#define PG8_BAR __builtin_amdgcn_s_barrier()
#define PG8_SCHED __builtin_amdgcn_sched_barrier(0)
    Unit cur, nxt; int ui = 0;
    if (!S.next(0, cur)) return;
    f32x4 acc[2][2][4][2];
#pragma unroll
    for (int a = 0; a < 2; ++a)
#pragma unroll
        for (int b = 0; b < 2; ++b)
#pragma unroll
            for (int m = 0; m < 4; ++m)
#pragma unroll
                for (int n = 0; n < 2; ++n) acc[a][b][m][n] = (f32x4){0.f, 0.f, 0.f, 0.f};
    bf16x8 At[4][2], B0[2][2], B1[2][2];
    const size_t khalf = (size_t)(nt >> 1) * kstep;
    const char* cA = (const char*)g.A + (size_t)cur.pm * tstep + (size_t)cur.h * hstep + (cur.part == 2 ? khalf : 0); const char* cB = (const char*)g.Bt + (size_t)cur.pn * tstep + (cur.part == 2 ? khalf : 0);
    S.a_ready(cur);
    if constexpr (SP2) {
        PG8_STAGE(PG8_SB(0, 0), cB, voffB); PG8_STAGE(PG8_SB(0, 1), cB + hstep, voffB); PG8_STAGE(PG8_SA(0, 0), cA, voffA); PG8_STAGE(PG8_SA(0, 1), cA + hstep, voffA);
        if (wr == 1) PG8_BAR;
        PG8_WAIT_V(2); PG8_BAR;
        PG8_STAGE(PG8_SB(1, 0), cB + kstep, voffB); PG8_STAGE(PG8_SA(1, 0), cA + kstep, voffA); PG8_STAGE(PG8_SB(1, 1), cB + hstep + kstep, voffB);
        PG8_WAIT_V(6); PG8_BAR;
    } else {
        PG8_STAGE(PG8_SB(0, 0), cB, voffB); PG8_STAGE(PG8_SA(0, 0), cA, voffA); PG8_STAGE(PG8_SB(0, 1), cB + hstep, voffB); PG8_STAGE(PG8_SA(0, 1), cA + hstep, voffA);
        if (wr == 1) PG8_BAR;
        PG8_WAIT_V(4); PG8_BAR;
        PG8_STAGE(PG8_SB(1, 0), cB + kstep, voffB); PG8_STAGE(PG8_SA(1, 0), cA + kstep, voffA); PG8_STAGE(PG8_SB(1, 1), cB + hstep + kstep, voffB);
        PG8_WAIT_V(6); PG8_BAR;
    }
    for (;;) {
        const bool has_next = S.next(ui + 1, nxt);
        const char* nA = has_next ? (const char*)g.A + (size_t)nxt.pm * tstep + (size_t)nxt.h * hstep + (nxt.part == 2 ? khalf : 0) : cA; const char* nB = has_next ? (const char*)g.Bt + (size_t)nxt.pn * tstep + (nxt.part == 2 ? khalf : 0) : cB;
        const int ntc = cur.part ? (nt >> 1) : nt;
        for (int t = 0; t < ntc; t += 2) {
            const bool last = (t == ntc - 2);
            const char* a1 = cA + (size_t)(t + 1) * kstep;
            const char* a2 = last ? nA : cA + (size_t)(t + 2) * kstep; const char* b2 = last ? nB : cB + (size_t)(t + 2) * kstep;
            const char* a3 = a2 + kstep; const char* b3 = b2 + kstep;
            if (last && has_next) S.a_ready(nxt);
            if constexpr (SP2) {
            PG8_LDB(B0, 0, 0); PG8_LDB(B1, 0, 1); PG8_SCHED; PG8_LDA(At, 0, 0); PG8_STAGE(PG8_SA(1, 1), a1 + hstep, voffA);
            PG8_WAIT_V(8); PG8_WAIT_L(0); PG8_BAR; PG8_MMA(0, 0, At, B0); PG8_MMA(0, 1, At, B1); PG8_BAR; PG8_SCHED;
            PG8_LDA(At, 0, 1); PG8_STAGE(PG8_SB(0, 0), b2, voffB); PG8_STAGE(PG8_SB(0, 1), b2 + hstep, voffB); PG8_STAGE(PG8_SA(0, 0), a2, voffA);
            PG8_WAIT_V(8); PG8_WAIT_L(0); PG8_BAR; if (!cur.half) { PG8_MMA(1, 0, At, B0); PG8_MMA(1, 1, At, B1); } PG8_BAR; PG8_SCHED;
            PG8_LDB(B0, 1, 0); PG8_LDB(B1, 1, 1); PG8_SCHED; PG8_LDA(At, 1, 0); PG8_STAGE(PG8_SA(0, 1), a2 + hstep, voffA);
            PG8_WAIT_V(8); PG8_WAIT_L(0); PG8_BAR; PG8_MMA(0, 0, At, B0); PG8_MMA(0, 1, At, B1); PG8_BAR; PG8_SCHED;
            PG8_LDA(At, 1, 1); PG8_STAGE(PG8_SB(1, 0), b3, voffB); PG8_STAGE(PG8_SB(1, 1), b3 + hstep, voffB); PG8_STAGE(PG8_SA(1, 0), a3, voffA);
            PG8_WAIT_V(8); PG8_WAIT_L(0); PG8_BAR; if (!cur.half) { PG8_MMA(1, 0, At, B0); PG8_MMA(1, 1, At, B1); } PG8_BAR; PG8_SCHED;
            } else {
            PG8_LDB(B0, 0, 0); PG8_SCHED; PG8_LDA(At, 0, 0); PG8_STAGE(PG8_SA(1, 1), a1 + hstep, voffA);
            PG8_WAIT_L(8); PG8_BAR; PG8_WAIT_L(0); PG8_MMA(0, 0, At, B0); PG8_BAR; PG8_SCHED;
            PG8_LDB(B1, 0, 1); PG8_STAGE(PG8_SB(0, 0), b2, voffB);
            PG8_BAR; PG8_WAIT_L(0); PG8_MMA(0, 1, At, B1); PG8_BAR;
            PG8_LDA(At, 0, 1); PG8_STAGE(PG8_SA(0, 0), a2, voffA);
            PG8_BAR; PG8_WAIT_L(0); PG8_MMA(1, 0, At, B0); PG8_BAR; PG8_SCHED;
            PG8_STAGE(PG8_SB(0, 1), b2 + hstep, voffB);
            PG8_WAIT_V(6); PG8_BAR; PG8_MMA(1, 1, At, B1); PG8_BAR;
            PG8_LDB(B0, 1, 0); PG8_SCHED; PG8_LDA(At, 1, 0); PG8_STAGE(PG8_SA(0, 1), a2 + hstep, voffA);
            PG8_WAIT_L(8); PG8_BAR; PG8_WAIT_L(0); PG8_MMA(0, 0, At, B0); PG8_BAR; PG8_SCHED;
            PG8_LDB(B1, 1, 1); PG8_STAGE(PG8_SB(1, 0), b3, voffB);
            PG8_BAR; PG8_WAIT_L(0); PG8_MMA(0, 1, At, B1); PG8_BAR;
            PG8_LDA(At, 1, 1); PG8_STAGE(PG8_SA(1, 0), a3, voffA);
            PG8_BAR; PG8_WAIT_L(0); PG8_MMA(1, 0, At, B0); PG8_BAR; PG8_SCHED;
            PG8_STAGE(PG8_SB(1, 1), b3 + hstep, voffB);
            PG8_WAIT_V(6); PG8_BAR; PG8_MMA(1, 1, At, B1); PG8_BAR;
            }
        }
        if constexpr (ALIGN_EPI) { if (wr == 0) PG8_BAR; }
        if constexpr (Sched::KSPLIT) {
            if (cur.part != 0) {
                const int own = cur.part - 1;
                const char* slb = (const char*)(S.slab + (size_t)cur.slab * 65536 + (size_t)(1 - own) * 32768); unsigned* flg = S.flags + 64 * (2 * cur.slab);
                const unsigned voff = (unsigned)tid * 16u;
                if (own == 0) {
#pragma unroll
                    for (int b = 0; b < 2; ++b)
#pragma unroll
                        for (int m = 0; m < 4; ++m)
#pragma unroll
                            for (int n = 0; n < 2; ++n) { const char* bi = slb + (size_t)(((b * 4 + m) * 2 + n) * 8192); asm volatile("global_store_dwordx4 %0, %1, %2 sc1" :: "v"(voff), "v"(acc[1][b][m][n]), "s"(bi) : "memory"); }
                } else {
#pragma unroll
                    for (int b = 0; b < 2; ++b)
#pragma unroll
                        for (int m = 0; m < 4; ++m)
#pragma unroll
                            for (int n = 0; n < 2; ++n) { const char* bi = slb + (size_t)(((b * 4 + m) * 2 + n) * 8192); asm volatile("global_store_dwordx4 %0, %1, %2 sc1" :: "v"(voff), "v"(acc[0][b][m][n]), "s"(bi) : "memory"); }
                }
                PG8_WAIT_V(0); PG8_BAR;
                if (tid == 0) __hip_atomic_store(flg + 64 * (1 - own), S.epoch, __ATOMIC_RELAXED, __HIP_MEMORY_SCOPE_AGENT);
                if (wid == 0) { unsigned sp = 0; while ((unsigned)__builtin_amdgcn_readfirstlane(__hip_atomic_load(flg + 64 * own, __ATOMIC_RELAXED, __HIP_MEMORY_SCOPE_AGENT)) != S.epoch) { __builtin_amdgcn_s_sleep(2); if (++sp > (1u << 18)) break; }
                    __builtin_amdgcn_fence(__ATOMIC_ACQUIRE, "agent"); PG8_WAIT_V(0); }
                PG8_BAR; asm volatile("" ::: "memory");
                cur.half = 1; cur.h = own;
            }
        }
        if constexpr (Sched::DYN) S.pre_epi(ui, tid);
        constexpr bool run_epi = true;
        if constexpr (!Epi::AFTER_DRAIN) { if (run_epi) { E(acc, cur, wr, wc, fr, fq); S.done(cur); } }
        if (!has_next) break;
#pragma unroll
        for (int a = 0; a < 2; ++a)
#pragma unroll
            for (int b = 0; b < 2; ++b)
#pragma unroll
                for (int m = 0; m < 4; ++m)
#pragma unroll
                    for (int n = 0; n < 2; ++n) acc[a][b][m][n] = (f32x4){0.f, 0.f, 0.f, 0.f};
        cur = nxt; cA = nA; cB = nB; ++ui;
        if constexpr (ALIGN_EPI) { if (wr == 1) PG8_BAR; }
    }
    PG8_WAIT_V(0);
    if constexpr (!ALIGN_EPI) { if (wr == 0) PG8_BAR; }
    PG8_BAR;
    if constexpr (Epi::AFTER_DRAIN) { E.fused(acc, cur, wr, wc, fr, fq, lds, wid, lane); S.done(cur); }
#undef PG8_SA
#undef PG8_SB
#undef PG8_STAGE
#undef PG8_LDA
#undef PG8_LDB
#undef PG8_MMA
#undef PG8_WAIT_V
#undef PG8_WAIT_L
#undef PG8_BAR
#undef PG8_SCHED
}
}

#define GAS __attribute__((address_space(1)))
#define LAS __attribute__((address_space(3)))
typedef unsigned short bf16;
typedef unsigned v4u __attribute__((ext_vector_type(4)));
typedef float f32x4 __attribute__((ext_vector_type(4)));
typedef short bf16x8 __attribute__((ext_vector_type(8)));
typedef GAS unsigned gu32;
typedef GAS unsigned long long gu64;
#define RLX_AGENT __ATOMIC_RELAXED, __HIP_MEMORY_SCOPE_AGENT
#define LDS_WAIT() asm volatile("s_waitcnt lgkmcnt(0)" ::: "memory")
#define VM_WAIT() asm volatile("s_waitcnt vmcnt(0)" ::: "memory")
__device__ __forceinline__ unsigned long long rt() { return __builtin_amdgcn_s_memrealtime(); }
__device__ __forceinline__ unsigned pk2(float lo, float hi) { unsigned r; asm("v_cvt_pk_bf16_f32 %0, %1, %2" : "=v"(r) : "v"(lo), "v"(hi)); return r; }
__device__ __forceinline__ unsigned f2bf(float f) { return pk2(f, f) & 0xffffu; }
#define XB_TMO      128
#define XB_XCNT(j)  (256  + 64 * (j))
#define XB_XSUB(j)  (1280 + 64 * (j))
#define XB_XGEN(j)  (2304 + 64 * (j))
#define XB_TOP      3328
#define XB_TOPGEN   3392
#define XCD_BAR_WORDS 3456
#define XB_SPIN_CAP (1u << 18)

__device__ __forceinline__ unsigned xb_ld(unsigned* p)              { return __hip_atomic_load(p, __ATOMIC_RELAXED, __HIP_MEMORY_SCOPE_AGENT); }
__device__ __forceinline__ unsigned xb_add(unsigned* p, unsigned v) { return __hip_atomic_fetch_add(p, v, __ATOMIC_RELAXED, __HIP_MEMORY_SCOPE_AGENT); }
__device__ __forceinline__ unsigned xb_xcc_id() { return (unsigned)__builtin_amdgcn_s_getreg((3 << 11) | 20) & 0xFu; }
#define XB_SPIN(cond, bar) do { unsigned _sp = 0; while (cond) { __builtin_amdgcn_s_sleep(1); \
    if ((++_sp & 255u) == 0u) { if (xb_ld(&(bar)[XB_TMO])) break; if (_sp > XB_SPIN_CAP) { atomicAdd(&(bar)[XB_TMO], 1u); break; } } } } while (0)

struct XcdBarrier {
    unsigned* bar; unsigned x;
    volatile LAS unsigned* st;
};

__device__ __forceinline__ XcdBarrier xcd_barrier_post(unsigned* bar, volatile LAS unsigned* st) {
    XcdBarrier b; b.bar = bar; b.x = xb_xcc_id(); b.st = st;
    if (tid_now() == 0) (void)xb_add(&bar[XB_XCNT(b.x)], 1u);
    return b;
}
__device__ __forceinline__ void xcd_barrier_complete(unsigned* bar, unsigned x, unsigned& nloc, unsigned& nx) {
    const unsigned G = gridDim.x * gridDim.y * gridDim.z;
    unsigned sum, cnt, mine, sp = 0u;
    for (;;) {
        sum = 0u; cnt = 0u; mine = 0u;
#pragma unroll
        for (unsigned j = 0; j < 16; ++j) { const unsigned c = xb_ld(&bar[XB_XCNT(j)]); sum += c; cnt += (c > 0u) ? 1u : 0u; mine = (j == x) ? c : mine; }
        if (sum == G) break;
        __builtin_amdgcn_s_sleep(1);
        if ((++sp & 255u) == 0u) { if (xb_ld(&bar[XB_TMO])) break; if (sp > XB_SPIN_CAP) { atomicAdd(&bar[XB_TMO], 1u); break; } }
    }
    nloc = mine > 0u ? mine : 1u; nx = cnt > 0u ? cnt : 1u;
}

__device__ __forceinline__ void xcd_barrier(const XcdBarrier& b) {
    asm volatile("s_waitcnt vmcnt(0)" ::: "memory");
    __syncthreads();
    if (tid_now() == 0) {
        unsigned* bar = b.bar;
        __builtin_amdgcn_s_waitcnt(0);
        unsigned nloc = b.st[0], nx = b.st[1];
        if (nloc == 0u) { xcd_barrier_complete(bar, b.x, nloc, nx); b.st[0] = nloc; b.st[1] = nx; }
        const unsigned old = xb_add(&bar[XB_XSUB(b.x)], 1u);
        const unsigned gen = old / nloc;
        if (old + 1u == (gen + 1u) * nloc) {
            __builtin_amdgcn_fence(__ATOMIC_RELEASE, "agent");
            asm volatile("s_waitcnt vmcnt(0)" ::: "memory");
            const unsigned og = xb_add(&bar[XB_TOP], 1u);
            const unsigned tg = og / nx;
            if (og + 1u == (tg + 1u) * nx) xb_add(&bar[XB_TOPGEN], 1u);
            else XB_SPIN(xb_ld(&bar[XB_TOPGEN]) == tg, bar);
            __builtin_amdgcn_fence(__ATOMIC_ACQUIRE, "agent");
            xb_add(&bar[XB_XGEN(b.x)], 1u);
            asm volatile("s_waitcnt vmcnt(0)" ::: "memory");
        } else {
            XB_SPIN(xb_ld(&bar[XB_XGEN(b.x)]) == gen, bar);
            __builtin_amdgcn_fence(__ATOMIC_ACQUIRE, "agent");
            asm volatile("s_waitcnt vmcnt(0)" ::: "memory");
        }
    }
    __syncthreads();
}

constexpr int DM = 2048, NB_P = 32, SEQ_P = 256, NB_S = 4, SEQ_S = 1024, PAST = 512, DEPTH = 4;
constexpr int MP = NB_P * SEQ_P, MS = NB_S * SEQ_S, MTOK = MP + MS;
constexpr int NHEAD = 8, HKV = 2, HD = 128;
constexpr int DIN = 5632, DFF = 5632, DUP = 2 * DFF, NMODC = 6 * DM;
constexpr int C_QR = 0, C_KR = 1024, C_VR = 2048, C_GR = 3072, C_QA = 4096, C_KA = 5120, C_VA = 5376;
constexpr int NCOND = 5;
constexpr float EPS = 1e-6f, LOG2E = 1.4426950408889634f;
constexpr float QK_SCALE = 0.08838834764831845f;
constexpr size_t OUT_Y = 0, OUT_CK = (size_t)MTOK * DM, OUT_CV = OUT_CK + (size_t)NB_P * DEPTH * HKV * SEQ_P * HD, OUT_ST = OUT_CV + (size_t)NB_P * DEPTH * HKV * SEQ_P * HD;
constexpr size_t OUT_TOTAL = OUT_ST + (size_t)NB_P * DEPTH * 2 * NHEAD * HD * HD;
constexpr size_t MiB = 1u << 20;
constexpr size_t WS_CTL = 0, CTL_ZERO_BYTES = 1 * MiB;
constexpr size_t WS_ROPE = 1 * MiB, WS_MOD = 2 * MiB, WS_MODP = 3 * MiB, WS_CKB = 18 * MiB, WS_CVB = 22 * MiB, WS_SRET = 26 * MiB;
constexpr size_t WS_WIN = 58 * MiB, WS_WOUT = 146 * MiB, WS_WUP = 178 * MiB, WS_WDN = 354 * MiB;
constexpr size_t WS_X = 442 * MiB, WS_H = 538 * MiB, WS_MIX = 586 * MiB, WS_ACT = 634 * MiB, WS_PROJ = 766 * MiB, WS_SLAB = 1032 * MiB, WS_END = 1064 * MiB;
constexpr size_t WS_RSS1 = WS_ROPE + 512 * 1024, WS_RSS2 = WS_RSS1 + 64 * 1024;
constexpr size_t WS_SWIN = 1030 * MiB, WS_SWUP = WS_SWIN + 512 * 1024;
constexpr size_t WS_HALO = WS_MODP + 2 * MiB;
constexpr int EX_OFF = 132096;
constexpr int KCH = 16;
constexpr int CW_BAR = 4096, CW_KS = 32768, CW_TK = 200000; constexpr int TK_SLOT = 131072 + 320 + 160;
constexpr int LDS_BYTES = 147456;
constexpr int MISC_OFF = 131072 + 320;
constexpr int NWAVES = 8;

typedef unsigned v2u __attribute__((ext_vector_type(2)));
struct Args;
typedef const __attribute__((address_space(4))) Args* ArgP;
struct Args { const float* in[19]; float* out; unsigned char* ws; int ph_lo, ph_hi; };

__device__ __forceinline__ float shx(float v, int o, int lane) { return __builtin_bit_cast(float, __builtin_amdgcn_ds_bpermute((lane ^ o) << 2, __builtin_bit_cast(int, v))); }
__device__ __forceinline__ unsigned shxu(unsigned v, int o, int lane) { return (unsigned)__builtin_amdgcn_ds_bpermute((lane ^ o) << 2, (int)v); }
__device__ __forceinline__ float wave_sum(float v, int lane) {
#pragma unroll
    for (int o = 1; o < 64; o <<= 1) v += shx(v, o, lane);
    return v;
}
struct Ids { int tid, lane, wave, bx, G, gw, NGW, gt, NGT; };
__device__ __forceinline__ Ids make_ids() {
    Ids I; int t = tid_now(); asm volatile("" : "+v"(t)); int bx = blockIdx.x, G = gridDim.x; asm volatile("" : "+s"(bx), "+s"(G));
    I.tid = t; I.lane = t & 63; I.wave = __builtin_amdgcn_readfirstlane(t >> 6); I.bx = bx; I.G = G;
    const int vcu = (G % 8 == 0) ? (bx % 8) * (G / 8) + bx / 8 : bx;
    I.gw = vcu * 8 + I.wave; I.NGW = G * 8; I.gt = I.gw * 64 + I.lane; I.NGT = I.NGW * 64; return I;
}
__device__ __forceinline__ ArgP launder(ArgP a) { asm volatile("" : "+s"(a)); return a; }
__device__ __forceinline__ float bf2f(unsigned short b) { return __builtin_bit_cast(float, (unsigned)b << 16); }
__device__ __forceinline__ float bflo(unsigned w) { return __builtin_bit_cast(float, w << 16); }
__device__ __forceinline__ float bfhi(unsigned w) { return __builtin_bit_cast(float, w & 0xffff0000u); }
__device__ __forceinline__ float silu_f(float x) { return x * __builtin_amdgcn_rcpf(1.f + __builtin_amdgcn_exp2f(-LOG2E * x)); }
__device__ __forceinline__ int cond_of_row(int row) { return row < MP ? 0 : 1 + ((row - MP) >> 10); }

__device__ __forceinline__ void transpose_load(const float* W, int N, int item, int lane, f32x4 (&wv)[8]) {
    const int nblk = N / 32, kb = item / nblk, nb = item % nblk, k0 = 64 * kb, n0 = 32 * nb;
#pragma unroll
    for (int i = 0; i < 8; ++i) wv[i] = __builtin_nontemporal_load((const GAS f32x4*)(W + (size_t)(k0 + 8 * i + (lane >> 3)) * N + n0 + 4 * (lane & 7)));
}
typedef float f32x16t __attribute__((ext_vector_type(16)));
template <bool REMAP_UP, bool SW>
__device__ __forceinline__ void transpose_item(const f32x4 (&wv)[8], int K, int N, bf16* WT, LAS float* scr, const LAS unsigned char* tabB, float* sw, int item, int lane) {
    const int nblk = N / 32, kb = item / nblk, nb = item % nblk, k0 = 64 * kb, n0 = 32 * nb;
    const int d0 = REMAP_UP ? (n0 < DFF ? (n0 >> 7) * 256 + (n0 & 127) : ((n0 - DFF) >> 7) * 256 + 128 + ((n0 - DFF) & 127)) : n0;
#pragma unroll
    for (int i = 0; i < 8; ++i) { LAS float* d = scr + (8 * i + (lane >> 3)) * 33 + 4 * (lane & 7); d[0] = wv[i].x; d[1] = wv[i].y; d[2] = wv[i].z; d[3] = wv[i].w; }
    LDS_WAIT(); asm volatile("" ::: "memory");
    if (SW) {
        const int n = lane & 31, hi = lane >> 5; f32x16t acc = (f32x16t){};
#pragma unroll
        for (int ks = 0; ks < 4; ++ks) { const LAS float* s = scr + ((2 * ks + hi) * 8) * 33 + n;
            v4u bw; bw.x = pk2(s[0 * 33], s[1 * 33]); bw.y = pk2(s[2 * 33], s[3 * 33]); bw.z = pk2(s[4 * 33], s[5 * 33]); bw.w = pk2(s[6 * 33], s[7 * 33]);
            const v4u aw = *(const LAS v4u*)(tabB + (((k0 >> 3) + 2 * ks + hi) * 8 + (lane & 7)) * 16);
            acc = __builtin_amdgcn_mfma_f32_32x32x16_bf16(__builtin_bit_cast(bf16x8, aw), __builtin_bit_cast(bf16x8, bw), acc, 0, 0, 0); }
#pragma unroll
        for (int r = 0; r < 4; ++r) { const int j = r + 4 * hi; if (j < NCOND) unsafeAtomicAdd(sw + (size_t)j * N + d0 + n, acc[r]); } }
    const int c = lane & 7;
#pragma unroll
    for (int j = 0; j < 4; ++j) { const int n = (lane >> 3) + 8 * j; const LAS float* s = scr + (8 * c) * 33 + n;
        v4u o; o.x = pk2(s[0 * 33], s[1 * 33]); o.y = pk2(s[2 * 33], s[3 * 33]); o.z = pk2(s[4 * 33], s[5 * 33]); o.w = pk2(s[6 * 33], s[7 * 33]);
        __builtin_nontemporal_store(o, (GAS v4u*)(WT + (size_t)(d0 + n) * K + k0 + 8 * c)); }
    LDS_WAIT(); asm volatile("" ::: "memory");
}
template <bool REMAP_UP, bool SW>
__device__ __forceinline__ void transpose_range(const float* W, int K, int N, bf16* WT, LAS float* scr, const LAS unsigned char* tab, float* sw, int s, int e, int wi, int nw, int lane) {
    int it = s + wi; if (it >= e) return;
    f32x4 cur[8]; transpose_load(W, N, it, lane, cur);
#pragma unroll 1
    for (; it < e; it += nw) { f32x4 nxt[8]; transpose_load(W, N, it + nw < e ? it + nw : it, lane, nxt);
        transpose_item<REMAP_UP, SW>(cur, K, N, WT, scr, tab, sw, it, lane);
#pragma unroll
        for (int i = 0; i < 8; ++i) cur[i] = nxt[i]; }
}
__device__ __forceinline__ void shift_frags(LAS unsigned char* tabB, const float* src, int tid) {
    for (int e = tid; e < 256 * 8; e += 512) { const int c = e >> 3, j = e & 7; v4u o = (v4u){0u, 0u, 0u, 0u};
        if (j < NCOND) { const f32x4 x0 = *(const GAS f32x4*)(src + (size_t)j * NMODC + 8 * c), x1 = *(const GAS f32x4*)(src + (size_t)j * NMODC + 8 * c + 4);
            o.x = pk2(x0[0], x0[1]); o.y = pk2(x0[2], x0[3]); o.z = pk2(x1[0], x1[1]); o.w = pk2(x1[2], x1[3]); }
        *(LAS v4u*)(tabB + e * 16) = o; }
}
constexpr int I_IN = (DM / 64) * (DIN / 32), I_OUT = (DM / 64) * (DM / 32), I_UP = (DM / 64) * (DUP / 32), I_DN = (DFF / 64) * (DM / 32), I_LAYER = I_IN + I_OUT + I_DN + I_UP;
__device__ __forceinline__ void convert_weights(ArgP a, LAS unsigned char* lds, int l, int lo, int hi, int wi, int nw, int tid) {
    asm volatile("" : "+v"(tid));
    const int lane = tid & 63, wave = __builtin_amdgcn_readfirstlane(tid >> 6);
    unsigned char* ws = a->ws; LAS float* scr = (LAS float*)(lds + wave * 8704); LAS unsigned char* tab = lds + 73728;
    const float* modl = (const float*)(ws + WS_MOD) + (size_t)l * NCOND * NMODC;
    int b0 = 0;
    { const int s = lo > b0 ? lo - b0 : 0, e = (hi < b0 + I_IN ? hi : b0 + I_IN) - b0;
        if (s < e) { __syncthreads(); shift_frags(tab, modl, tid); __syncthreads();
            transpose_range<false, true>(a->in[9] + (size_t)l * DM * DIN, DM, DIN, (bf16*)(ws + WS_WIN) + (size_t)l * DIN * DM, scr, tab, (float*)(ws + WS_SWIN) + (size_t)l * NCOND * DIN, s, e, wi, nw, lane); } }
    b0 += I_IN;
    { const int s = lo > b0 ? lo - b0 : 0, e = (hi < b0 + I_OUT ? hi : b0 + I_OUT) - b0;
        transpose_range<false, false>(a->in[10] + (size_t)l * DM * DM, DM, DM, (bf16*)(ws + WS_WOUT) + (size_t)l * DM * DM, scr, tab, nullptr, s, e, wi, nw, lane); }
    b0 += I_OUT;
    { const int s = lo > b0 ? lo - b0 : 0, e = (hi < b0 + I_DN ? hi : b0 + I_DN) - b0;
        transpose_range<false, false>(a->in[17] + (size_t)l * DFF * DM, DFF, DM, (bf16*)(ws + WS_WDN) + (size_t)l * DM * DFF, scr, tab, nullptr, s, e, wi, nw, lane); }
    b0 += I_DN;
    { const int s = lo > b0 ? lo - b0 : 0, e = (hi < b0 + I_UP ? hi : b0 + I_UP) - b0;
        if (s < e) { __syncthreads(); shift_frags(tab, modl + 3 * DM, tid); __syncthreads();
            transpose_range<true, true>(a->in[14] + (size_t)l * DM * DUP, DM, DUP, (bf16*)(ws + WS_WUP) + (size_t)l * DUP * DM, scr, tab, (float*)(ws + WS_SWUP) + (size_t)l * NCOND * DUP, s, e, wi, nw, lane); } }
    __syncthreads();
}

__device__ __forceinline__ void phase_prologue_a(ArgP a, LAS unsigned char* lds) {
    a = launder(a); const Ids I = make_ids(); const int tid = I.tid, lane = I.lane, wave = I.wave, gw = I.gw, NGW = I.NGW;
    unsigned char* ws = a->ws;
    LAS float* tab = (LAS float*)(lds + 73728);
    for (int i = tid; i < NCOND * DM; i += 512) { const int j = i / DM, k = i % DM; const float x = (j == 0) ? a->in[6][k] : a->in[5][(j - 1) * DM + k]; tab[i] = silu_f(x); }
    __syncthreads();
    {
        float* modp = (float*)(ws + WS_MODP);
        typedef float f32x2 __attribute__((ext_vector_type(2)));
        constexpr int NCB = NMODC / 128, NIT = DEPTH * KCH * NCB, RB = 16, NRB = 128 / RB;
        if (gw < NIT) {
            f32x2 acc[NCOND], wa[RB], wb[RB];
#pragma unroll
            for (int j = 0; j < NCOND; ++j) acc[j] = (f32x2){0.f, 0.f};
#define MOD_LOAD(buf, it_, r_) do { const float* W_ = a->in[7] + ((size_t)((it_) / (NCB * KCH)) * DM + (size_t)(((it_) / NCB) % KCH) * 128 + (size_t)(r_) * RB) * NMODC + ((it_) % NCB) * 128 + lane * 2; \
            _Pragma("unroll") for (int i_ = 0; i_ < RB; ++i_) buf[i_] = __builtin_nontemporal_load((const GAS f32x2*)(W_ + (size_t)i_ * NMODC)); } while (0)
#define MOD_ACC(buf, it_, r_) do { const int kc_ = ((it_) / NCB) % KCH, kb_ = kc_ * 128 + (r_) * RB; \
            _Pragma("unroll") for (int i_ = 0; i_ < RB; ++i_) { _Pragma("unroll") for (int j = 0; j < NCOND; ++j) acc[j] += tab[j * DM + kb_ + i_] * buf[i_]; } \
            if ((r_) == NRB - 1) { const int cb_ = (it_) % NCB, l_ = (it_) / (NCB * KCH); \
                _Pragma("unroll") for (int j = 0; j < NCOND; ++j) { *(GAS f32x2*)(modp + ((size_t)(kc_ * DEPTH + l_) * NCOND + j) * NMODC + cb_ * 128 + lane * 2) = acc[j]; acc[j] = (f32x2){0.f, 0.f}; } } } while (0)
            int it = gw, r = 0;
            MOD_LOAD(wa, it, r);
#pragma unroll 1
            for (;;) {
                int nit = it, nr = r + 1; if (nr == NRB) { nr = 0; nit = it + NGW; }
                bool has = nit < NIT;
                if (has) MOD_LOAD(wb, nit, nr);
                MOD_ACC(wa, it, r);
                if (!has) break;
                it = nit; r = nr;
                nr = r + 1; if (nr == NRB) { nr = 0; nit = it + NGW; }
                has = nit < NIT;
                if (has) MOD_LOAD(wa, nit, nr);
                MOD_ACC(wb, it, r);
                if (!has) break;
                it = nit; r = nr;
            }
#undef MOD_LOAD
#undef MOD_ACC
        }
    }
    const int gt = gw * 64 + lane, NGT = NGW * 64;
    { float* swz = (float*)(ws + WS_SWIN); for (int i = gt; i < (int)((2 * MiB) / 4); i += NGT) swz[i] = 0.f; }
    {
        float* rope = (float*)(ws + WS_ROPE);
        for (int i = gt; i < SEQ_S * 32; i += NGT) { const int t = i >> 5, k = i & 31;
            const float inv = exp2f(-(float)k * (13.287712379549449f / 32.f));
            const float rr = (float)(t >> 6) * inv * 0.15915494309189535f, rc = (float)(t & 63) * inv * 0.15915494309189535f;
            const float fr_ = rr - floorf(rr), fc_ = rc - floorf(rc);
            rope[t * 128 + k] = __builtin_amdgcn_cosf(fr_); rope[t * 128 + 32 + k] = __builtin_amdgcn_sinf(fr_);
            rope[t * 128 + 64 + k] = __builtin_amdgcn_cosf(fc_); rope[t * 128 + 96 + k] = __builtin_amdgcn_sinf(fc_); }
    }
    {
        constexpr int NC8 = NB_S * DEPTH * HKV * PAST * HD / 8;
        for (int i0 = gt; i0 < 2 * NC8; i0 += 4 * NGT) {
            f32x4 x0[4], x1[4];
#pragma unroll
            for (int q = 0; q < 4; ++q) { const int i = i0 + q * NGT; if (i < 2 * NC8) { const bool isk = i < NC8; const int j = isk ? i : i - NC8;
                const float* src = (isk ? a->in[2] : a->in[3]) + (size_t)j * 8; x0[q] = *(const GAS f32x4*)src; x1[q] = *(const GAS f32x4*)(src + 4); } }
#pragma unroll
            for (int q = 0; q < 4; ++q) { const int i = i0 + q * NGT; if (i < 2 * NC8) { const bool isk = i < NC8; const int j = isk ? i : i - NC8;
                v4u o; o.x = pk2(x0[q][0], x0[q][1]); o.y = pk2(x0[q][2], x0[q][3]); o.z = pk2(x1[q][0], x1[q][1]); o.w = pk2(x1[q][2], x1[q][3]);
                *(GAS v4u*)((bf16*)(ws + (isk ? WS_CKB : WS_CVB)) + (size_t)j * 8) = o; } }
        }
    }
}
__device__ __forceinline__ void phase_prologue_b(ArgP a) {
    a = launder(a); const Ids I = make_ids(); const int gt = I.gt, NGT = I.NGT;
    const float* modp = (const float*)(a->ws + WS_MODP); float* mod = (float*)(a->ws + WS_MOD);
    constexpr int N4 = DEPTH * NCOND * NMODC / 4;
    for (int i = gt; i < N4; i += NGT) { const int c4 = i % (NMODC / 4), lj = i / (NMODC / 4), l = lj / NCOND, j = lj % NCOND;
        f32x4 s = *(const GAS f32x4*)(a->in[8] + (size_t)l * NMODC + c4 * 4);
#pragma unroll
        for (int kc = 0; kc < KCH; ++kc) s += *(const GAS f32x4*)(modp + ((size_t)(kc * DEPTH + l) * NCOND + j) * NMODC + c4 * 4);
        *(GAS f32x4*)(mod + (size_t)lj * NMODC + c4 * 4) = s; }
}
typedef float f32x16p __attribute__((ext_vector_type(16)));
__device__ __forceinline__ void phase_prologue_c(ArgP a, LAS unsigned char* lds) {
    a = launder(a); const Ids I = make_ids(); const int lane = I.lane, gw = I.gw, NGW = I.NGW;
    unsigned char* ws = a->ws;
    convert_weights(a, lds, 0, 0, I_IN + I_OUT, gw, NGW, I.tid);
    convert_weights(a, lds, 0, I_IN + I_OUT + I_DN, I_LAYER, gw, NGW, I.tid);
    bf16* XS = (bf16*)(ws + WS_H); float* rss = (float*)(ws + WS_RSS1);
    if (gw < MTOK) {
        f32x4 v[8], w[8];
#define XROW(m_) ((const GAS f32x4*)((m_) < MP ? a->in[0] + (size_t)(m_) * DM : a->in[1] + (size_t)((m_) - MP) * DM) + lane)
        { const GAS f32x4* xr = XROW(gw);
#pragma unroll
            for (int j = 0; j < 8; ++j) v[j] = xr[64 * j]; }
#pragma unroll 1
        for (int m = gw; m < MTOK; m += NGW) {
            { const int mn = m + NGW < MTOK ? m + NGW : m; const GAS f32x4* xr = XROW(mn);
#pragma unroll
                for (int j = 0; j < 8; ++j) w[j] = xr[64 * j]; }
            const float* sc = (const float*)(ws + WS_MOD) + (size_t)cond_of_row(m) * NMODC + DM;
            float s = 0.f;
#pragma unroll
            for (int j = 0; j < 8; ++j) s += (v[j].x * v[j].x + v[j].y * v[j].y) + (v[j].z * v[j].z + v[j].w * v[j].w);
            s = wave_sum(s, lane); if (lane == 0) rss[m] = s;
            GAS unsigned long long* o8 = (GAS unsigned long long*)(XS + (size_t)m * DM) + lane;
#pragma unroll
            for (int j = 0; j < 8; ++j) { const f32x4 h = v[j] * (*(const GAS f32x4*)(sc + (lane + 64 * j) * 4) + 1.f);
                o8[64 * j] = (unsigned long long)pk2(h.x, h.y) | ((unsigned long long)pk2(h.z, h.w) << 32); }
#pragma unroll
            for (int j = 0; j < 8; ++j) v[j] = w[j];
        }
#undef XROW
    }
}
__device__ __forceinline__ void zero_f32(float* p, int n, int gt, int NGT) { for (int i = gt; i < n; i += NGT) p[i] = 0.f; }
__device__ __forceinline__ void phase_final(ArgP a) {
    a = launder(a); const Ids I = make_ids(); const int lane = I.lane, gw = I.gw, NGW = I.NGW;
    const float* X = (const float*)(a->ws + WS_X); const float* gain = a->in[18];
    if (gw < MTOK) {
        f32x4 v[8], w[8];
        { const GAS f32x4* xr = (const GAS f32x4*)(X + (size_t)gw * DM) + lane;
#pragma unroll
            for (int j = 0; j < 8; ++j) v[j] = xr[64 * j]; }
#pragma unroll 1
        for (int m = gw; m < MTOK; m += NGW) {
            { const int mn = m + NGW < MTOK ? m + NGW : m; const GAS f32x4* xr = (const GAS f32x4*)(X + (size_t)mn * DM) + lane;
#pragma unroll
                for (int j = 0; j < 8; ++j) w[j] = xr[64 * j]; }
            float s = 0.f;
#pragma unroll
            for (int j = 0; j < 8; ++j) s += (v[j].x * v[j].x + v[j].y * v[j].y) + (v[j].z * v[j].z + v[j].w * v[j].w);
            const float r = 1.f / sqrtf(wave_sum(s, lane) * (1.f / DM) + EPS);
            GAS f32x4* o = (GAS f32x4*)(a->out + OUT_Y + (size_t)m * DM) + lane;
#pragma unroll
            for (int j = 0; j < 8; ++j) o[64 * j] = v[j] * r * *(const GAS f32x4*)(gain + (lane + 64 * j) * 4);
#pragma unroll
            for (int j = 0; j < 8; ++j) v[j] = w[j];
        }
    }
}
namespace pg8 {
struct EpiUp {
    static constexpr bool PERM = true, AFTER_DRAIN = false;
    bf16_t* O; const float* rss; const float* sw;
    __device__ __forceinline__ void operator()(const f32x4 (&acc)[2][2][4][2], const Unit& u, int wr, int wc, int fr, int fq) const {
        const int row0 = u.pm * BM + wr * 64 + fr, col0 = u.pn * BM + wc * 32 + 8 * fq;
        const int cond = u.pm < MP / BM ? 0 : 1 + ((u.pm - MP / BM) >> 2);
        f32x4 sv[2][2];
#pragma unroll
        for (int bj = 0; bj < 2; ++bj)
#pragma unroll
            for (int n = 0; n < 2; ++n) sv[bj][n] = *(const f32x4*)(sw + (size_t)cond * DUP + col0 + bj * HALF + 4 * n);
#pragma unroll
        for (int ai = 0; ai < 2; ++ai)
#pragma unroll
            for (int m = 0; m < 4; ++m) { const int row = row0 + ai * HALF + m * 16; const float r = 1.f / sqrtf(rss[row] * (1.f / DM) + EPS);
                bf16_t* rowp = O + (size_t)row * DUP + col0;
#pragma unroll
                for (int bj = 0; bj < 2; ++bj) { const f32x4 v0 = acc[ai][bj][m][0] * r + sv[bj][0], v1 = acc[ai][bj][m][1] * r + sv[bj][1];
                    u32x4 w; w.x = cvt_pk_bf16(v0[0], v0[1]); w.y = cvt_pk_bf16(v0[2], v0[3]); w.z = cvt_pk_bf16(v1[0], v1[1]); w.w = cvt_pk_bf16(v1[2], v1[3]);
                    *(u32x4*)(rowp + bj * HALF) = w; } }
    }
};
template <int CTRL> __device__ __forceinline__ float dpp1(float old, float src) { return __builtin_bit_cast(float, __builtin_amdgcn_update_dpp(__builtin_bit_cast(int, old), __builtin_bit_cast(int, src), CTRL, 0xf, 0xf, false)); }
template <bool SHR> __device__ __forceinline__ f32x4 dpp4(f32x4 old, f32x4 src) {
    f32x4 r; r.x = dpp1<SHR ? 0x111 : 0x101>(old.x, src.x); r.y = dpp1<SHR ? 0x111 : 0x101>(old.y, src.y); r.z = dpp1<SHR ? 0x111 : 0x101>(old.z, src.z); r.w = dpp1<SHR ? 0x111 : 0x101>(old.w, src.w); return r; }
template <int CTRL> __device__ __forceinline__ float dppm1(float src) { return __builtin_bit_cast(float, __builtin_amdgcn_mov_dpp(__builtin_bit_cast(int, src), CTRL, 0xf, 0xf, false)); }
__device__ __forceinline__ f32x4 ror1_4(f32x4 x) { f32x4 r; r.x = dppm1<0x121>(x.x); r.y = dppm1<0x121>(x.y); r.z = dppm1<0x121>(x.z); r.w = dppm1<0x121>(x.w); return r; }
__device__ __forceinline__ f32x4 rol1_4(f32x4 x) { f32x4 r; r.x = dppm1<0x12F>(x.x); r.y = dppm1<0x12F>(x.y); r.z = dppm1<0x12F>(x.z); r.w = dppm1<0x12F>(x.w); return r; }
struct EpiUpConv {
    static constexpr bool PERM = true, AFTER_DRAIN = false;
    bf16_t* ACT; const float* rss; const float* sw; const float* cw; const float* cb; float* halo; PG8_LAS float* ex;
    __device__ __forceinline__ void operator()(const f32x4 (&acc)[2][2][4][2], const Unit& u, int wr, int wc, int fr, int fq) const {
        const int rowb = u.pm * BM + wr * 64 + fr, colt = u.pn * BM + wc * 32 + 8 * fq, ocol = u.pn * HALF + wc * 32 + 8 * fq;
        const bool ctx = u.pm < MP / BM; const int st = u.pm - MP / BM, cond = ctx ? 0 : 1 + (st >> 2);
        const bool has_above = !ctx && (st & 3) != 0, has_below = !ctx && (st & 3) != 3;
        float r[2][4]; f32x4 sv[2][2];
#pragma unroll
        for (int ai = 0; ai < 2; ++ai)
#pragma unroll
            for (int m = 0; m < 4; ++m) r[ai][m] = 1.f / sqrtf(rss[rowb + ai * HALF + m * 16] * (1.f / DM) + EPS);
#pragma unroll
        for (int bj = 0; bj < 2; ++bj)
#pragma unroll
            for (int n = 0; n < 2; ++n) sv[bj][n] = *(const f32x4*)(sw + (size_t)cond * DUP + colt + bj * HALF + 4 * n);
#define NRM(ai, bj, m, n) (acc[ai][bj][m][n] * r[ai][m] + sv[bj][n])
        if (fr == 0 || fr == 15) { const int edge = fr == 0 ? 0 : 1;
#pragma unroll
            for (int ai = 0; ai < 2; ++ai)
#pragma unroll
                for (int bj = 0; bj < 2; ++bj)
#pragma unroll
                    for (int n = 0; n < 2; ++n) { const f32x4 v = edge ? NRM(ai, bj, 3, n) : NRM(ai, bj, 0, n);
                        *(PG8_LAS f32x4*)(ex + ((((wr * 4 + wc) * 2 + ai) * 2 + edge) * 2 + bj) * 32 + fq * 8 + n * 4) = v; } }
        if (has_above && wr == 0 && fr < 2) {
#pragma unroll
            for (int bj = 0; bj < 2; ++bj)
#pragma unroll
                for (int n = 0; n < 2; ++n) *(f32x4*)(halo + (size_t)((st * 2 + 0) * 2 + fr) * DUP + colt + bj * HALF + 4 * n) = NRM(0, bj, 0, n); }
        if (has_below && wr == 1 && fr >= 14) {
#pragma unroll
            for (int bj = 0; bj < 2; ++bj)
#pragma unroll
                for (int n = 0; n < 2; ++n) *(f32x4*)(halo + (size_t)((st * 2 + 1) * 2 + (fr - 14)) * DUP + colt + bj * HALF + 4 * n) = NRM(1, bj, 3, n); }
        asm volatile("s_waitcnt lgkmcnt(0)" ::: "memory"); __builtin_amdgcn_s_barrier(); asm volatile("" ::: "memory");
        typedef unsigned u32x2v __attribute__((ext_vector_type(2)));
        u32x2v outp[2][4][2];
        const f32x4 z4 = {0.f, 0.f, 0.f, 0.f};
#pragma unroll
        for (int n = 0; n < 2; ++n) {
            f32x4 wg[3], wv[3];
#pragma unroll
            for (int j = 0; j < 3; ++j) { wg[j] = *(const f32x4*)(cw + (size_t)j * DUP + ocol + 4 * n); wv[j] = *(const f32x4*)(cw + (size_t)j * DUP + DFF + ocol + 4 * n); }
            const f32x4 bg = *(const f32x4*)(cb + ocol + 4 * n), bvv = *(const f32x4*)(cb + DFF + ocol + 4 * n);
#pragma unroll
            for (int ai = 0; ai < 2; ++ai) {
                f32x4 tg[4], tv[4];
#pragma unroll
                for (int m = 0; m < 4; ++m) { tg[m] = NRM(ai, 0, m, n); tv[m] = NRM(ai, 1, m, n); }
                f32x4 ag = z4, av = z4, lg = z4, lv = z4;
                { int sw_ = -1, sa_ = 0;
                    if (wr == 1) { sw_ = 0; sa_ = ai; } else if (ai == 1) { sw_ = 1; sa_ = 0; }
                    if (sw_ >= 0) { const PG8_LAS float* q = ex + ((((sw_ * 4 + wc) * 2 + sa_) * 2 + 1) * 2) * 32 + fq * 8 + n * 4; ag = *(const PG8_LAS f32x4*)q; av = *(const PG8_LAS f32x4*)(q + 32); }
                    int tw_ = -1, ta_ = 0;
                    if (wr == 0) { tw_ = 1; ta_ = ai; } else if (ai == 0) { tw_ = 0; ta_ = 1; }
                    if (tw_ >= 0) { const PG8_LAS float* q = ex + ((((tw_ * 4 + wc) * 2 + ta_) * 2 + 0) * 2) * 32 + fq * 8 + n * 4; lg = *(const PG8_LAS f32x4*)q; lv = *(const PG8_LAS f32x4*)(q + 32); } }
#pragma unroll
                for (int m = 0; m < 4; ++m) {
                    const f32x4 pg = dpp4<true>(m == 0 ? ag : ror1_4(tg[m == 0 ? 0 : m - 1]), tg[m]), pv = dpp4<true>(m == 0 ? av : ror1_4(tv[m == 0 ? 0 : m - 1]), tv[m]);
                    const f32x4 ng = dpp4<false>(m == 3 ? lg : rol1_4(tg[m == 3 ? 3 : m + 1]), tg[m]), nv = dpp4<false>(m == 3 ? lv : rol1_4(tv[m == 3 ? 3 : m + 1]), tv[m]);
                    const f32x4 ug = bg + wg[0] * pg + wg[1] * tg[m] + wg[2] * ng, uv = bvv + wv[0] * pv + wv[1] * tv[m] + wv[2] * nv;
                    f32x4 o;
#pragma unroll
                    for (int e = 0; e < 4; ++e) o[e] = ug[e] * __builtin_amdgcn_rcpf(1.f + __builtin_amdgcn_exp2f(-1.4426950408889634f * ug[e])) * uv[e];
                    outp[ai][m][n].x = cvt_pk_bf16(o[0], o[1]); outp[ai][m][n].y = cvt_pk_bf16(o[2], o[3]);
                }
            }
        }
#undef NRM
#pragma unroll
        for (int ai = 0; ai < 2; ++ai)
#pragma unroll
            for (int m = 0; m < 4; ++m) { u32x4 w; w.x = outp[ai][m][0].x; w.y = outp[ai][m][0].y; w.z = outp[ai][m][1].x; w.w = outp[ai][m][1].y;
                *(u32x4*)(ACT + (size_t)(rowb + ai * HALF + m * 16) * DFF + ocol) = w; }
    }
};
struct EpiIn {
    static constexpr bool PERM = true, AFTER_DRAIN = false;
    bf16_t* O; float* ck; float* cv; int layer; const float* rss; const float* sw;
    __device__ __forceinline__ void operator()(const f32x4 (&acc)[2][2][4][2], const Unit& u, int wr, int wc, int fr, int fq) const {
        const int row0 = u.pm * BM + u.h * HALF + wr * 64 + fr, col0 = u.pn * BM + wc * 32 + 8 * fq;
        const int cond = u.pm < MP / BM ? 0 : 1 + ((u.pm - MP / BM) >> 2);
        const bool cache = (u.pn >= C_KA / BM && u.pm < MP / BM); float* dst = (u.pn == C_KA / BM) ? ck : cv;
        f32x4 sv[2][2];
#pragma unroll
        for (int bj = 0; bj < 2; ++bj)
#pragma unroll
            for (int n = 0; n < 2; ++n) sv[bj][n] = *(const f32x4*)(sw + (size_t)cond * DIN + col0 + bj * HALF + 4 * n);
#pragma unroll
        for (int ai = 0; ai < 2; ++ai) { if (ai == 1 && u.half) break;
#pragma unroll
            for (int m = 0; m < 4; ++m) { const int row = row0 + ai * HALF + m * 16; const float r = 1.f / sqrtf(rss[row] * (1.f / DM) + EPS);
                bf16_t* rowp = O + (size_t)row * DIN + col0;
#pragma unroll
                for (int bj = 0; bj < 2; ++bj) { const f32x4 v0 = acc[ai][bj][m][0] * r + sv[bj][0], v1 = acc[ai][bj][m][1] * r + sv[bj][1];
                    u32x4 w; w.x = cvt_pk_bf16(v0[0], v0[1]); w.y = cvt_pk_bf16(v0[2], v0[3]); w.z = cvt_pk_bf16(v1[0], v1[1]); w.w = cvt_pk_bf16(v1[2], v1[3]);
                    *(u32x4*)(rowp + bj * HALF) = w;
                    if (cache) { float* p = dst + ((((size_t)(row >> 8) * DEPTH + layer) * HKV + bj) * SEQ_P + (row & 255)) * HD + wc * 32 + 8 * fq; __builtin_nontemporal_store(v0, (f32x4*)p); __builtin_nontemporal_store(v1, (f32x4*)(p + 4)); } } } }
    }
};
#ifndef EPIRES_MH
#define EPIRES_MH 2
#endif
struct EpiRes {
    static constexpr bool PERM = false, AFTER_DRAIN = false;
    const float* xin_p; const float* xin_s; float* X; const float* gate; const float* scale_next; bf16_t* XS; float* rss; int dry; const float* slab;
    __device__ __forceinline__ void operator()(const f32x4 (&acc)[2][2][4][2], const Unit& u, int wr, int wc, int fr, int fq) const {
        if (dry) return;
        asm volatile("" : "+v"(fr), "+v"(fq));
        const int row0 = u.pm * BM + u.h * HALF + wr * 64 + fr, col0 = u.pn * BM + wc * 32 + 4 * fq;
        const bool ctx = u.pm < MP / BM; const int cond = ctx ? 0 : 1 + ((u.pm - MP / BM) >> 2);
        const float* xin = ctx ? xin_p : xin_s - (size_t)MP * DM;
        const float* g = gate + (size_t)cond * NMODC + col0;
        const float* part = u.part ? slab + (size_t)u.slab * 65536 + (size_t)u.h * 32768 + (size_t)(((wr * 4 + wc) * 4 + fq) * 16 + fr) * 4 : nullptr;
        const int xsperm = (fq & 1) * 16 + (fq >> 1) * 8 - 4 * fq;
        f32x4 gv[2][2], sv[2][2];
#pragma unroll
        for (int bj = 0; bj < 2; ++bj)
#pragma unroll
            for (int n = 0; n < 2; ++n) { gv[bj][n] = *(const f32x4*)(g + bj * HALF + n * 16); sv[bj][n] = scale_next ? *(const f32x4*)(scale_next + (size_t)cond * NMODC + col0 + bj * HALF + n * 16) + 1.f : (f32x4){1.f, 1.f, 1.f, 1.f}; }
#pragma unroll
        for (int ai = 0; ai < 2; ++ai) { if (ai == 1 && u.half) break;
#pragma unroll
          for (int mh = 0; mh < EPIRES_MH; ++mh) {
            f32x4 xv[4][2][2];
#pragma unroll
            for (int m = (4 / EPIRES_MH) * mh; m < (4 / EPIRES_MH) * (mh + 1); ++m)
#pragma unroll
                for (int bj = 0; bj < 2; ++bj)
#pragma unroll
                    for (int n = 0; n < 2; ++n) xv[m][bj][n] = *(const f32x4*)(xin + (size_t)(row0 + ai * HALF + m * 16) * DM + col0 + bj * HALF + n * 16);
#pragma unroll
            for (int m = (4 / EPIRES_MH) * mh; m < (4 / EPIRES_MH) * (mh + 1); ++m) { const int row = row0 + ai * HALF + m * 16; const size_t off = (size_t)row * DM + col0; float ss = 0.f;
#pragma unroll
                for (int bj = 0; bj < 2; ++bj) { unsigned wx[2], wy[2];
#pragma unroll
                    for (int n = 0; n < 2; ++n) { const size_t o = off + bj * HALF + n * 16; f32x4 av = acc[ai][bj][m][n]; if (part) av = (u.h ? acc[1][bj][m][n] : acc[0][bj][m][n]) + *(const f32x4*)(part + ((bj * 4 + m) * 2 + n) * 2048);
                        const f32x4 x = xv[m][bj][n] + gv[bj][n] * av; *(f32x4*)(X + o) = x;
                        if (scale_next) { ss += (x[0] * x[0] + x[1] * x[1]) + (x[2] * x[2] + x[3] * x[3]); const f32x4 h = x * sv[bj][n]; wx[n] = cvt_pk_bf16(h[0], h[1]); wy[n] = cvt_pk_bf16(h[2], h[3]); } }
                    if (scale_next) {
                        const auto rx = __builtin_amdgcn_permlane16_swap(wx[0], wx[1], false, false), ry = __builtin_amdgcn_permlane16_swap(wy[0], wy[1], false, false);
                        u32x4 w4; w4.x = rx[0]; w4.y = ry[0]; w4.z = rx[1]; w4.w = ry[1];
                        *(u32x4*)(XS + off + bj * HALF + xsperm) = w4; } }
                if (scale_next) { { const int ln = fq * 16 + fr; ss += shx(ss, 16, ln); ss += shx(ss, 32, ln); } if (fq == 0) unsafeAtomicAdd(rss + row, ss); } }
            asm volatile("" ::: "memory"); } }
    }
};
}

__device__ __forceinline__ void unpack8(v4u w, float (&f)[8]) { f[0] = bflo(w.x); f[1] = bfhi(w.x); f[2] = bflo(w.y); f[3] = bfhi(w.y); f[4] = bflo(w.z); f[5] = bfhi(w.z); f[6] = bflo(w.w); f[7] = bfhi(w.w); }
__device__ __forceinline__ f32x4 silu4_mul(f32x4 g, f32x4 v) { f32x4 o;
#pragma unroll
    for (int e = 0; e < 4; ++e) o[e] = g[e] * __builtin_amdgcn_rcpf(1.f + __builtin_amdgcn_exp2f(-LOG2E * g[e])) * v[e]; return o; }
__device__ __forceinline__ void phase_convfix(ArgP a, int l) {
    a = launder(a); const Ids I = make_ids();
    const float* halo = (const float*)(a->ws + WS_HALO); bf16* ACT = (bf16*)(a->ws + WS_ACT);
    const float* cw = a->in[15] + (size_t)l * 3 * DUP; const float* cb = a->in[16] + (size_t)l * DUP;
    for (int idx = I.gt; idx < 12 * (DFF / 4); idx += I.NGT) {
        const int bd = idx / (DFF / 4), ocol = (idx % (DFF / 4)) * 4, st = (bd / 3) * 4 + bd % 3, gcol = (ocol >> 7) * 256 + (ocol & 127);
        const float* hu = halo + (size_t)((st * 2 + 1) * 2) * DUP; const float* hl = halo + (size_t)(((st + 1) * 2 + 0) * 2) * DUP;
        const f32x4 Ag = *(const GAS f32x4*)(hu + gcol), Bg = *(const GAS f32x4*)(hu + DUP + gcol), Cg = *(const GAS f32x4*)(hl + gcol), Dg = *(const GAS f32x4*)(hl + DUP + gcol);
        const f32x4 Av = *(const GAS f32x4*)(hu + gcol + 128), Bv = *(const GAS f32x4*)(hu + DUP + gcol + 128), Cv = *(const GAS f32x4*)(hl + gcol + 128), Dv = *(const GAS f32x4*)(hl + DUP + gcol + 128);
        f32x4 wg[3], wv[3];
#pragma unroll
        for (int j = 0; j < 3; ++j) { wg[j] = *(const GAS f32x4*)(cw + (size_t)j * DUP + ocol); wv[j] = *(const GAS f32x4*)(cw + (size_t)j * DUP + DFF + ocol); }
        const f32x4 bg = *(const GAS f32x4*)(cb + ocol), bv = *(const GAS f32x4*)(cb + DFF + ocol);
        const f32x4 o255 = silu4_mul(bg + wg[0] * Ag + wg[1] * Bg + wg[2] * Cg, bv + wv[0] * Av + wv[1] * Bv + wv[2] * Cv);
        const f32x4 o0 = silu4_mul(bg + wg[0] * Bg + wg[1] * Cg + wg[2] * Dg, bv + wv[0] * Bv + wv[1] * Cv + wv[2] * Dv);
        v2u w; w.x = pk2(o255[0], o255[1]); w.y = pk2(o255[2], o255[3]); *(GAS v2u*)(ACT + (size_t)(MP + st * 256 + 255) * DFF + ocol) = w;
        w.x = pk2(o0[0], o0[1]); w.y = pk2(o0[2], o0[3]); *(GAS v2u*)(ACT + (size_t)(MP + (st + 1) * 256) * DFF + ocol) = w;
    }
}

typedef float f32x16 __attribute__((ext_vector_type(16)));
typedef short s16x4 __attribute__((ext_vector_type(4)));
#define KSWZ(row, colB) ((row) * 256 + ((colB) ^ (((row) & 7) << 4)))
#define SBAR() __builtin_amdgcn_sched_barrier(0)
__device__ __forceinline__ int crow(int r, int hi) { return (r & 3) + 8 * (r >> 2) + 4 * hi; }
__device__ __forceinline__ unsigned cvtpk(float lo, float hi) { unsigned r; asm volatile("v_cvt_pk_bf16_f32 %0, %1, %2" : "=v"(r) : "v"(lo), "v"(hi)); return r; }
__device__ __forceinline__ int v_st(int k, int c) { const int kk = (k & ~0xC) | ((k & 4) << 1) | ((k & 8) >> 1); return ((kk >> 3) * 4 + (c >> 5)) * 512 + ((kk & 7) * 32 + (c & 31)) * 2; }
__device__ __forceinline__ int v_rd_base(int lane) { return ((lane & 3) << 3) | (((lane >> 2) & 3) << 6) | (((lane >> 4) & 1) << 5) | (((lane >> 5) & 1) << 8); }
constexpr int v_rd_off(int d0, int ks, int half) { return d0 * 512 + ks * 4096 + half * 2048; }
template <int OFF> __device__ __forceinline__ s16x4 tr_read(int vb) { s16x4 r; asm volatile("ds_read_b64_tr_b16 %0, %1 offset:%2" : "=&v"(r) : "v"(vb), "i"(OFF) : "memory"); return r; }
#define PKLH(L, H) (bf16x8){L[0], L[1], L[2], L[3], H[0], H[1], H[2], H[3]}
template <int D0> __device__ __forceinline__ void pv_one(f32x16& od, int vb, bf16x8 pa0, bf16x8 pa1, bf16x8 pa2, bf16x8 pa3) {
    const s16x4 l0 = tr_read<v_rd_off(D0, 0, 0)>(vb), h0 = tr_read<v_rd_off(D0, 0, 1)>(vb), l1 = tr_read<v_rd_off(D0, 1, 0)>(vb), h1 = tr_read<v_rd_off(D0, 1, 1)>(vb);
    const s16x4 l2 = tr_read<v_rd_off(D0, 2, 0)>(vb), h2 = tr_read<v_rd_off(D0, 2, 1)>(vb), l3 = tr_read<v_rd_off(D0, 3, 0)>(vb), h3 = tr_read<v_rd_off(D0, 3, 1)>(vb);
    asm volatile("s_waitcnt lgkmcnt(0)" ::: "memory"); SBAR();
    od = __builtin_amdgcn_mfma_f32_32x32x16_bf16(pa0, PKLH(l0, h0), od, 0, 0, 0);
    od = __builtin_amdgcn_mfma_f32_32x32x16_bf16(pa1, PKLH(l1, h1), od, 0, 0, 0);
    od = __builtin_amdgcn_mfma_f32_32x32x16_bf16(pa2, PKLH(l2, h2), od, 0, 0, 0);
    od = __builtin_amdgcn_mfma_f32_32x32x16_bf16(pa3, PKLH(l3, h3), od, 0, 0, 0);
}
__device__ __forceinline__ void pack_p(const f32x16& p0, const f32x16& p1, bf16x8& pa0, bf16x8& pa1, bf16x8& pa2, bf16x8& pa3) {
#define PK4(P, BASE, OUT) do { unsigned a0 = cvtpk(P[BASE + 0], P[BASE + 1]), a1 = cvtpk(P[BASE + 2], P[BASE + 3]);   \
    unsigned b0 = cvtpk(P[BASE + 4], P[BASE + 5]), b1 = cvtpk(P[BASE + 6], P[BASE + 7]);                              \
    auto r0 = __builtin_amdgcn_permlane32_swap(a0, b0, false, false); auto r1 = __builtin_amdgcn_permlane32_swap(a1, b1, false, false); \
    v4u w = {r0[0], r1[0], r0[1], r1[1]}; OUT = __builtin_bit_cast(bf16x8, w); } while (0)
    PK4(p0, 0, pa0); PK4(p0, 8, pa1); PK4(p1, 0, pa2); PK4(p1, 8, pa3);
#undef PK4
}
__device__ __forceinline__ void qkt(f32x16& p0, f32x16& p1, LAS const unsigned char* Ks, const bf16x8 (&qr)[8], int r32, int hi) {
    p0 = (f32x16){}; p1 = (f32x16){};
#pragma unroll
    for (int d0 = 0; d0 < 8; ++d0) { const int cb = (d0 * 16 + hi * 8) * 2;
        const bf16x8 b0 = *(LAS const bf16x8*)(Ks + KSWZ(r32, cb));
        const bf16x8 b1 = *(LAS const bf16x8*)(Ks + KSWZ(32 + r32, cb));
        p0 = __builtin_amdgcn_mfma_f32_32x32x16_bf16(b0, qr[d0], p0, 0, 0, 0);
        p1 = __builtin_amdgcn_mfma_f32_32x32x16_bf16(b1, qr[d0], p1, 0, 0, 0); }
}
constexpr float ATT_THR = 8.f;
__device__ __forceinline__ void partialSM(f32x16& p0, f32x16& p1, float& m_reg, float& alpha) {
    constexpr float C = QK_SCALE * LOG2E;
    float pmax = p0[0];
#pragma unroll
    for (int r = 1; r < 16; ++r) pmax = fmaxf(pmax, p0[r]);
#pragma unroll
    for (int r = 0; r < 16; ++r) pmax = fmaxf(pmax, p1[r]);
    { auto rr = __builtin_amdgcn_permlane32_swap(__float_as_uint(pmax), __float_as_uint(pmax), false, false); pmax = fmaxf(__uint_as_float(rr[0]), __uint_as_float(rr[1])); }
    float mn;
    if (__builtin_expect(__all(pmax - m_reg <= ATT_THR / QK_SCALE), 1)) { mn = m_reg; alpha = 1.f; }
    else { mn = fmaxf(m_reg, pmax); alpha = __builtin_amdgcn_exp2f((m_reg - mn) * C); m_reg = mn; }
    const float mnC = -mn * C;
#pragma unroll
    for (int r = 0; r < 16; ++r) p0[r] = fmaf(p0[r], C, mnC);
#pragma unroll
    for (int r = 0; r < 16; ++r) p1[r] = fmaf(p1[r], C, mnC);
#pragma unroll
    for (int r = 0; r < 16; ++r) p0[r] = __builtin_amdgcn_exp2f(p0[r]);
}
__device__ __forceinline__ void finishSM(f32x16& p0, f32x16& p1, float alpha, float& l_reg, bf16x8& pa0, bf16x8& pa1, bf16x8& pa2, bf16x8& pa3) {
#pragma unroll
    for (int r = 0; r < 16; ++r) p1[r] = __builtin_amdgcn_exp2f(p1[r]);
    float ps = 0.f;
#pragma unroll
    for (int r = 0; r < 16; ++r) ps += p0[r];
#pragma unroll
    for (int r = 0; r < 16; ++r) ps += p1[r];
    { auto rr = __builtin_amdgcn_permlane32_swap(__float_as_uint(ps), __float_as_uint(ps), false, false); ps = __uint_as_float(rr[0]) + __uint_as_float(rr[1]); }
    l_reg = l_reg * alpha + ps;
    pack_p(p0, p1, pa0, pa1, pa2, pa3);
}
__device__ __forceinline__ v4u rope8(v4u x, v4u y, bool first, const f32x4 (&cs)[2], const f32x4 (&sn)[2]) {
    float xf[8], yf[8], o[8]; unpack8(x, xf); unpack8(y, yf);
#pragma unroll
    for (int e = 0; e < 8; ++e) { const float c = cs[e >> 2][e & 3], s = sn[e >> 2][e & 3]; o[e] = first ? xf[e] * c - yf[e] * s : xf[e] * c + yf[e] * s; }
    v4u w; w.x = pk2(o[0], o[1]); w.y = pk2(o[2], o[3]); w.z = pk2(o[4], o[5]); w.w = pk2(o[6], o[7]); return w;
}

struct AttnTile { const bf16* kp; const bf16* vp; int stride; int tok; };
template <bool LATENT>
__device__ __forceinline__ void attn_unit(ArgP a, LAS unsigned char* lds, int l, int unit, int tid) {
    asm volatile("" : "+v"(tid));
    const int lane = tid & 63, wid = __builtin_amdgcn_readfirstlane(tid >> 6), r32 = lane & 31, hi = lane >> 5;
    const bf16* P = (const bf16*)(a->ws + WS_PROJ); bf16* MIX = (bf16*)(a->ws + WS_MIX);
    const float* rope = (const float*)(a->ws + WS_ROPE);
    int b, head, t0, row0, nt_win, tok_lo;
    if (LATENT) { b = unit >> 5; head = (unit >> 2) & 7; const int qb = unit & 3; t0 = qb * 256; row0 = MP + b * SEQ_S + t0;
        tok_lo = t0 - 128 < 0 ? 0 : t0 - 128; const int tok_hi = t0 + 384 > SEQ_S ? SEQ_S : t0 + 384; nt_win = (tok_hi - tok_lo) >> 6; }
    else { b = unit >> 3; head = unit & 7; t0 = 0; row0 = b * SEQ_P; nt_win = 0; tok_lo = 0; }
    const int hkv = head >> 2, NT = LATENT ? nt_win + PAST / 64 : SEQ_P / 64;
    LAS unsigned char* Vl = lds; LAS unsigned char* Kl = lds + 16384; LAS float* wsc = (LAS float*)(lds + 32768 + 256 * wid);
    bf16x8 qr[8];
    { const bf16* Qw = P + (size_t)(row0 + wid * 32 + r32) * DIN + C_QA + head * HD + hi * 8;
        v4u q[8];
#pragma unroll
        for (int d0 = 0; d0 < 8; ++d0) q[d0] = *(const GAS v4u*)(Qw + d0 * 16);
        if (LATENT) { const float* rt = rope + (size_t)(t0 + wid * 32 + r32) * 128;
#pragma unroll
            for (int hf = 0; hf < 2; ++hf)
#pragma unroll
                for (int j = 0; j < 2; ++j) { const int i0 = j * 16 + hi * 8;
                    f32x4 cs[2], sn[2]; cs[0] = *(const GAS f32x4*)(rt + hf * 64 + i0); cs[1] = *(const GAS f32x4*)(rt + hf * 64 + i0 + 4); sn[0] = *(const GAS f32x4*)(rt + hf * 64 + 32 + i0); sn[1] = *(const GAS f32x4*)(rt + hf * 64 + 32 + i0 + 4);
                    const v4u x1 = q[hf * 4 + j], x2 = q[hf * 4 + j + 2];
                    q[hf * 4 + j] = rope8(x1, x2, true, cs, sn); q[hf * 4 + j + 2] = rope8(x2, x1, false, cs, sn); } }
#pragma unroll
        for (int d0 = 0; d0 < 8; ++d0) qr[d0] = __builtin_bit_cast(bf16x8, q[d0]);
    }
    const float sink_raw = a->in[13][l * NHEAD + head] * (1.f / QK_SCALE);
    float m_reg = sink_raw, l_reg = 1.f; f32x16 o[4] = {};
    const int sr = tid >> 4, sc = (tid & 15) * 8, vst0 = v_st(sr, sc), vst1 = v_st(32 + sr, sc), vb0 = (int)(uintptr_t)Vl + v_rd_base(lane);
    const size_t cbase = LATENT ? (((size_t)b * DEPTH + l) * HKV + hkv) * PAST * HD : 0;
    auto tile_of = [&](int ti) -> AttnTile { AttnTile T;
        if (LATENT && ti < nt_win) { const int tok = tok_lo + ti * 64; T.kp = P + (size_t)(MP + b * SEQ_S + tok) * DIN + C_KA + hkv * HD; T.vp = P + (size_t)(MP + b * SEQ_S + tok) * DIN + C_VA + hkv * HD; T.stride = DIN; T.tok = tok; }
        else if (LATENT) { const int j = ti - nt_win; T.kp = (const bf16*)(a->ws + WS_CKB) + cbase + (size_t)j * 64 * HD; T.vp = (const bf16*)(a->ws + WS_CVB) + cbase + (size_t)j * 64 * HD; T.stride = HD; T.tok = -1; }
        else { T.kp = P + (size_t)(row0 + ti * 64) * DIN + C_KA + hkv * HD; T.vp = P + (size_t)(row0 + ti * 64) * DIN + C_VA + hkv * HD; T.stride = DIN; T.tok = -1; }
        return T; };
    v4u kA, kB, vA, vB;
    { const AttnTile T = tile_of(0); kA = *(const GAS v4u*)(T.kp + (size_t)sr * T.stride + sc); kB = *(const GAS v4u*)(T.kp + (size_t)(32 + sr) * T.stride + sc);
        vA = *(const GAS v4u*)(T.vp + (size_t)sr * T.stride + sc); vB = *(const GAS v4u*)(T.vp + (size_t)(32 + sr) * T.stride + sc); }
    for (int ti = 0; ti < NT; ++ti) {
        const AttnTile T = tile_of(ti);
        __syncthreads();
        if (LATENT && T.tok >= 0) {
            const bool first = ((sc >> 5) & 1) == 0; const int hf = sc >> 6, i0 = sc & 31;
            v4u pA, pB; pA.x = shxu(kA.x, 4, lane); pA.y = shxu(kA.y, 4, lane); pA.z = shxu(kA.z, 4, lane); pA.w = shxu(kA.w, 4, lane);
            pB.x = shxu(kB.x, 4, lane); pB.y = shxu(kB.y, 4, lane); pB.z = shxu(kB.z, 4, lane); pB.w = shxu(kB.w, 4, lane);
            { const float* rt = rope + (size_t)(T.tok + sr) * 128 + hf * 64 + i0; f32x4 cs[2], sn[2]; cs[0] = *(const GAS f32x4*)rt; cs[1] = *(const GAS f32x4*)(rt + 4); sn[0] = *(const GAS f32x4*)(rt + 32); sn[1] = *(const GAS f32x4*)(rt + 36); kA = rope8(kA, pA, first, cs, sn); }
            { const float* rt = rope + (size_t)(T.tok + 32 + sr) * 128 + hf * 64 + i0; f32x4 cs[2], sn[2]; cs[0] = *(const GAS f32x4*)rt; cs[1] = *(const GAS f32x4*)(rt + 4); sn[0] = *(const GAS f32x4*)(rt + 32); sn[1] = *(const GAS f32x4*)(rt + 36); kB = rope8(kB, pB, first, cs, sn); }
        }
        *(LAS v4u*)(Vl + vst0) = vA; *(LAS v4u*)(Vl + vst1) = vB;
        *(LAS v4u*)(Kl + KSWZ(sr, sc * 2)) = kA; *(LAS v4u*)(Kl + KSWZ(32 + sr, sc * 2)) = kB;
        if (ti + 1 < NT) { const AttnTile N = tile_of(ti + 1); kA = *(const GAS v4u*)(N.kp + (size_t)sr * N.stride + sc); kB = *(const GAS v4u*)(N.kp + (size_t)(32 + sr) * N.stride + sc);
            vA = *(const GAS v4u*)(N.vp + (size_t)sr * N.stride + sc); vB = *(const GAS v4u*)(N.vp + (size_t)(32 + sr) * N.stride + sc); }
        __syncthreads();
        bool skip = false, domask = false; const int qlo = t0 + wid * 32;
        if (LATENT && T.tok >= 0) { skip = (T.tok > qlo + 31 + 128) || (T.tok + 63 < qlo - 128); domask = !((T.tok >= qlo + 31 - 128) && (T.tok + 63 <= qlo + 128)); }
        if (!skip) {
            f32x16 p0, p1; float alpha; bf16x8 pa0, pa1, pa2, pa3;
            SBAR(); qkt(p0, p1, Kl, qr, r32, hi); SBAR();
            if (domask) { const int qt = qlo + r32;
#pragma unroll
                for (int r = 0; r < 16; ++r) { const int k0 = T.tok + crow(r, hi), d0 = k0 - qt, d1 = d0 + 32;
                    if (d0 > 128 || d0 < -128) p0[r] = -1e30f; if (d1 > 128 || d1 < -128) p1[r] = -1e30f; } }
            partialSM(p0, p1, m_reg, alpha);
            if (__any(alpha < 1.f)) { if (hi == 0) wsc[r32] = alpha; asm volatile("s_waitcnt lgkmcnt(0)" ::: "memory");
#pragma unroll
                for (int d = 0; d < 4; ++d)
#pragma unroll
                    for (int r = 0; r < 16; ++r) o[d][r] *= wsc[crow(r, hi)]; }
            finishSM(p0, p1, alpha, l_reg, pa0, pa1, pa2, pa3); SBAR();
            pv_one<0>(o[0], vb0, pa0, pa1, pa2, pa3); pv_one<1>(o[1], vb0, pa0, pa1, pa2, pa3); pv_one<2>(o[2], vb0, pa0, pa1, pa2, pa3); pv_one<3>(o[3], vb0, pa0, pa1, pa2, pa3);
        }
    }
    asm volatile("s_waitcnt lgkmcnt(0)" ::: "memory");
    if (hi == 0) wsc[32 + r32] = l_reg; asm volatile("s_waitcnt lgkmcnt(0)" ::: "memory");
    bf16* Ow = MIX + (size_t)(row0 + wid * 32) * DM + 1024 + head * HD + r32;
#pragma unroll
    for (int r = 0; r < 16; ++r) { const int orow = crow(r, hi); const float rl = __builtin_amdgcn_rcpf(wsc[32 + orow]);
#pragma unroll
        for (int d0 = 0; d0 < 4; ++d0) Ow[(size_t)orow * DM + d0 * 32] = (bf16)f2bf(o[d0][r] * rl); }
}
__device__ __forceinline__ void phase_attn(ArgP a, LAS unsigned char* lds, int l) {
    a = launder(a); const Ids I = make_ids();
    const int vcu = (I.G % 8 == 0) ? (I.bx % 8) * (I.G / 8) + I.bx / 8 : I.bx;
    for (int s = vcu; s < 256; s += I.G) {
        if (s < 128) attn_unit<true>(a, lds, l, s, I.tid);
        else {
#pragma unroll 1
            for (int k = 0; k < 2; ++k) attn_unit<false>(a, lds, l, 2 * (s - 128) + k, I.tid); }
    }
    __syncthreads();
}


constexpr size_t SRET_S_OFF = 0, SRET_P_OFF = (size_t)NB_S * NHEAD * 2 * 8 * HD * HD * 2;
template <int KS> __device__ __forceinline__ void kv_step(f32x16 (&acc)[2], int kb, int vb) {
    const s16x4 al = tr_read<v_rd_off(0, KS, 0)>(kb), ah = tr_read<v_rd_off(0, KS, 1)>(kb);
    const s16x4 b0l = tr_read<v_rd_off(0, KS, 0)>(vb), b0h = tr_read<v_rd_off(0, KS, 1)>(vb), b1l = tr_read<v_rd_off(1, KS, 0)>(vb), b1h = tr_read<v_rd_off(1, KS, 1)>(vb);
    asm volatile("s_waitcnt lgkmcnt(0)" ::: "memory"); SBAR();
    acc[0] = __builtin_amdgcn_mfma_f32_32x32x16_bf16(PKLH(al, ah), PKLH(b0l, b0h), acc[0], 0, 0, 0);
    acc[1] = __builtin_amdgcn_mfma_f32_32x32x16_bf16(PKLH(al, ah), PKLH(b1l, b1h), acc[1], 0, 0, 0);
}
__device__ __forceinline__ void ret_state_unit(ArgP a, LAS unsigned char* lds, int l, int unit, bool sample, int tid) {
    asm volatile("" : "+v"(tid));
    const int lane = tid & 63, wid = __builtin_amdgcn_readfirstlane(tid >> 6), r32 = lane & 31, hi = lane >> 5;
    const int b = unit >> 4, h = (unit >> 1) & 7, dir = unit & 1;
    const bf16* P = (const bf16*)(a->ws + WS_PROJ);
    const int N = sample ? 8 : 2, rowbase = sample ? MP + b * SEQ_S : b * SEQ_P;
    const float lg2 = a->in[11][(l * 2 + dir) * NHEAD + h] * LOG2E, cdec = exp2f(lg2 * 128.f);
    const int wa = wid >> 1, wb = (wid & 1) * 2;
    f32x16 acc[2];
    if (sample) { const float* s0 = a->in[4] + ((((size_t)b * DEPTH + l) * 2 + dir) * NHEAD + h) * HD * HD;
#pragma unroll
        for (int n = 0; n < 2; ++n)
#pragma unroll
            for (int r = 0; r < 16; ++r) acc[n][r] = s0[(size_t)(32 * wa + crow(r, hi)) * HD + 32 * (wb + n) + r32]; }
    else { acc[0] = (f32x16){}; acc[1] = (f32x16){}; }
    const int sr = tid >> 4, sc = (tid & 15) * 8;
    const int kb = (int)(uintptr_t)lds + v_rd_base(lane) + wa * 512, vb = (int)(uintptr_t)lds + 32768 + v_rd_base(lane) + wb * 512;
    unsigned char* sret = a->ws + WS_SRET + (sample ? SRET_S_OFF + (size_t)((b * NHEAD + h) * 2 + dir) * 8 * HD * HD * 2 : SRET_P_OFF + (size_t)((b * NHEAD + h) * 2 + dir) * HD * HD * 2);
    const int nsteps = sample ? 8 : 2;
    const bf16* kp0 = P + (size_t)rowbase * DIN + C_KR + h * HD + sc; const bf16* vp0 = P + (size_t)rowbase * DIN + C_VR + h * HD + sc;
    v4u kk[4], vv[4];
    { const int n0 = dir ? N - 1 : 0;
#pragma unroll
        for (int j = 0; j < 4; ++j) { kk[j] = *(const GAS v4u*)(kp0 + (size_t)(n0 * 128 + sr + 32 * j) * DIN); vv[j] = *(const GAS v4u*)(vp0 + (size_t)(n0 * 128 + sr + 32 * j) * DIN); } }
    for (int i = 0; i < nsteps; ++i) {
        const int n = dir ? N - 1 - i : i;
        if (sample || i == 1) { bf16* St = (bf16*)(sret + (sample ? (size_t)n * HD * HD * 2 : 0));
#pragma unroll
            for (int nn = 0; nn < 2; ++nn)
#pragma unroll
                for (int g = 0; g < 4; g += 2) {
                    unsigned ax = cvtpk(acc[nn][4 * g], acc[nn][4 * g + 1]), ay = cvtpk(acc[nn][4 * g + 2], acc[nn][4 * g + 3]);
                    unsigned bx = cvtpk(acc[nn][4 * g + 4], acc[nn][4 * g + 5]), by = cvtpk(acc[nn][4 * g + 6], acc[nn][4 * g + 7]);
                    const auto rx = __builtin_amdgcn_permlane32_swap(ax, bx, false, false), ry = __builtin_amdgcn_permlane32_swap(ay, by, false, false);
                    v4u w; w.x = rx[0]; w.y = ry[0]; w.z = rx[1]; w.w = ry[1];
                    *(GAS v4u*)(St + (size_t)(32 * (wb + nn) + r32) * HD + 32 * wa + 8 * g + 8 * hi) = w; } }
        if (sample && i == nsteps - 1) break;
        __syncthreads();
#pragma unroll
        for (int j = 0; j < 4; ++j) { const int c = sr + 32 * j; const float sc_ = QK_SCALE * __builtin_amdgcn_exp2f(lg2 * (float)(dir ? c : 127 - c));
            float f[8]; unpack8(kk[j], f); v4u w; w.x = pk2(f[0] * sc_, f[1] * sc_); w.y = pk2(f[2] * sc_, f[3] * sc_); w.z = pk2(f[4] * sc_, f[5] * sc_); w.w = pk2(f[6] * sc_, f[7] * sc_);
            *(LAS v4u*)(lds + (c >> 6) * 16384 + v_st(c & 63, sc)) = w; *(LAS v4u*)(lds + 32768 + (c >> 6) * 16384 + v_st(c & 63, sc)) = vv[j]; }
        { const int i2 = i + 1 < nsteps ? i + 1 : i, n2 = dir ? N - 1 - i2 : i2;
#pragma unroll
            for (int j = 0; j < 4; ++j) { kk[j] = *(const GAS v4u*)(kp0 + (size_t)(n2 * 128 + sr + 32 * j) * DIN); vv[j] = *(const GAS v4u*)(vp0 + (size_t)(n2 * 128 + sr + 32 * j) * DIN); } }
        __syncthreads();
#pragma unroll
        for (int r = 0; r < 16; ++r) { acc[0][r] *= cdec; acc[1][r] *= cdec; }
        kv_step<0>(acc, kb, vb); kv_step<1>(acc, kb, vb); kv_step<2>(acc, kb, vb); kv_step<3>(acc, kb, vb);
        kv_step<0>(acc, kb + 16384, vb + 16384); kv_step<1>(acc, kb + 16384, vb + 16384); kv_step<2>(acc, kb + 16384, vb + 16384); kv_step<3>(acc, kb + 16384, vb + 16384);
    }
    if (!sample) { float* out = a->out + OUT_ST + ((((size_t)b * DEPTH + l) * 2 + dir) * NHEAD + h) * HD * HD;
#pragma unroll
        for (int n = 0; n < 2; ++n)
#pragma unroll
            for (int r = 0; r < 16; ++r) __builtin_nontemporal_store(acc[n][r], out + (size_t)(32 * wa + crow(r, hi)) * HD + 32 * (wb + n) + r32); }
    __syncthreads();
}

__device__ __forceinline__ void cross_term(f32x16& od, LAS const unsigned char* St, int d0, const bf16x8 (&qr)[8], int r32, int hi, float lg2, int cq0, bool fwd) {
    f32x16 acc = (f32x16){};
#pragma unroll
    for (int ks = 0; ks < 8; ++ks) { const bf16x8 bfrag = *(LAS const bf16x8*)(St + KSWZ(32 * d0 + r32, (ks * 16 + hi * 8) * 2)); acc = __builtin_amdgcn_mfma_f32_32x32x16_bf16(qr[ks], bfrag, acc, 0, 0, 0); }
#pragma unroll
    for (int r = 0; r < 16; ++r) { const int cq = cq0 + crow(r, hi); od[r] += acc[r] * __builtin_amdgcn_exp2f(lg2 * (float)(fwd ? cq + 1 : 128 - cq)); }
}
struct RetPre { v4u kk[4], vv[4], sf[4], sb[4]; };
struct RetUnit { int ch, h, rowbase, b, n; bool sample, has_f, has_b; };
__device__ __forceinline__ RetUnit ret_unit_of(int unit) { RetUnit U; U.ch = unit >> 3; U.h = unit & 7; U.rowbase = U.ch * 128; U.sample = U.ch >= 64;
    U.b = U.sample ? (U.ch - 64) >> 3 : U.ch >> 1; U.n = U.sample ? (U.ch - 64) & 7 : U.ch & 1; U.has_f = U.sample || U.n == 1; U.has_b = U.sample || U.n == 0; return U; }
__device__ __forceinline__ void ret_out_load(ArgP a, const RetUnit& U, RetPre& R, int tid) {
    asm volatile("" : "+v"(tid));
    const int sr = tid >> 4, sc = (tid & 15) * 8;
    const bf16* P = (const bf16*)(a->ws + WS_PROJ); const unsigned char* sbase = a->ws + WS_SRET;
    const bf16* Sf = (const bf16*)(sbase + (U.sample ? SRET_S_OFF + ((size_t)(((U.b * NHEAD + U.h) * 2 + 0) * 8 + U.n)) * HD * HD * 2 : SRET_P_OFF + (size_t)((U.b * NHEAD + U.h) * 2 + 0) * HD * HD * 2));
    const bf16* Sb = (const bf16*)(sbase + (U.sample ? SRET_S_OFF + ((size_t)(((U.b * NHEAD + U.h) * 2 + 1) * 8 + U.n)) * HD * HD * 2 : SRET_P_OFF + (size_t)((U.b * NHEAD + U.h) * 2 + 1) * HD * HD * 2));
    const bf16* kp = P + (size_t)U.rowbase * DIN + C_KR + U.h * HD + sc; const bf16* vp = P + (size_t)U.rowbase * DIN + C_VR + U.h * HD + sc;
#pragma unroll
    for (int j = 0; j < 4; ++j) { R.kk[j] = *(const GAS v4u*)(kp + (size_t)(sr + 32 * j) * DIN); R.vv[j] = *(const GAS v4u*)(vp + (size_t)(sr + 32 * j) * DIN); }
#pragma unroll
    for (int j = 0; j < 4; ++j) { R.sf[j] = U.has_f ? *(const GAS v4u*)(Sf + (size_t)(sr + 32 * j) * HD + sc) : (v4u){0u, 0u, 0u, 0u}; R.sb[j] = U.has_b ? *(const GAS v4u*)(Sb + (size_t)(sr + 32 * j) * HD + sc) : (v4u){0u, 0u, 0u, 0u}; }
}
__device__ __forceinline__ void phase_mix2(ArgP a, LAS unsigned char* lds, int l) {
    a = launder(a); const Ids I = make_ids();
    const int vcu = (I.G % 8 == 0) ? (I.bx % 8) * (I.G / 8) + I.bx / 8 : I.bx;
    constexpr int NU = 96 * NHEAD;
    RetPre R;
#define LBAR() do { asm volatile("s_waitcnt lgkmcnt(0)" ::: "memory"); __builtin_amdgcn_s_barrier(); asm volatile("" ::: "memory"); } while (0)
    int tab_h = -1; LAS float* gnt = (LAS float*)(lds + EX_OFF);
    int u = vcu;
    if (u < NU) { const RetUnit U0 = ret_unit_of(u); ret_out_load(a, U0, R, I.tid); }
#pragma unroll 1
    for (; u < NU; u += I.G) {
        int tid = I.tid; asm volatile("" : "+v"(tid));
        const int lane = tid & 63, wid = __builtin_amdgcn_readfirstlane(tid >> 6), r32 = lane & 31, hi = lane >> 5;
        const int sr = tid >> 4, sc = (tid & 15) * 8, wq = wid & 3, wd = wid >> 2;
        const bf16* P = (const bf16*)(a->ws + WS_PROJ); bf16* MIX = (bf16*)(a->ws + WS_MIX);
        LAS unsigned char* Kt = lds; LAS unsigned char* Vi = lds + 32768; LAS unsigned char* Stf = lds + 65536; LAS unsigned char* Stb = lds + 98304;
        const RetUnit U = ret_unit_of(u);
        const float lgf2 = a->in[11][(l * 2 + 0) * NHEAD + U.h] * LOG2E, lgb2 = a->in[11][(l * 2 + 1) * NHEAD + U.h] * LOG2E;
        LBAR();
        if (U.h != tab_h) { tab_h = U.h; if (tid < HD) gnt[tid] = a->in[12][l * 1024 + U.h * HD + tid]; }
#pragma unroll
        for (int j = 0; j < 4; ++j) { const int c = sr + 32 * j; *(LAS v4u*)(Kt + KSWZ(c, sc * 2)) = R.kk[j]; *(LAS v4u*)(Vi + (c >> 6) * 16384 + v_st(c & 63, sc)) = R.vv[j];
            *(LAS v4u*)(Stf + KSWZ(c, sc * 2)) = R.sf[j]; *(LAS v4u*)(Stb + KSWZ(c, sc * 2)) = R.sb[j]; }
        bf16x8 qr[8];
        { const bf16* Qw = P + (size_t)(U.rowbase + wq * 32 + r32) * DIN + C_QR + U.h * HD + hi * 8;
#pragma unroll
            for (int d0 = 0; d0 < 8; ++d0) qr[d0] = __builtin_bit_cast(bf16x8, *(const GAS v4u*)(Qw + d0 * 16)); }
        const int erow = tid >> 2, eqd = tid & 3;
        v4u gw[4];
        { const bf16* gp = P + (size_t)(U.rowbase + erow) * DIN + C_GR + U.h * HD + 32 * eqd;
#pragma unroll
            for (int j = 0; j < 4; ++j) gw[j] = *(const GAS v4u*)(gp + 8 * j); }
        LBAR();
        f32x16 p0, p1, p2, p3;
        SBAR(); qkt(p0, p1, Kt, qr, r32, hi); SBAR(); qkt(p2, p3, Kt + 16384, qr, r32, hi); SBAR();
        { const int c = wq * 32 + r32;
#define DECAY(PX, KB) _Pragma("unroll") for (int r = 0; r < 16; ++r) { const int d = c - ((KB) * 32 + crow(r, hi)); \
            const float ex = __builtin_amdgcn_exp2f((d > 0 ? lgf2 : -lgb2) * (float)d); PX[r] *= (d == 0 ? 2.f * QK_SCALE : ex * QK_SCALE); }
            DECAY(p0, 0) DECAY(p1, 1) DECAY(p2, 2) DECAY(p3, 3)
#undef DECAY
        }
        bf16x8 pa0, pa1, pa2, pa3, pb0, pb1, pb2, pb3;
        pack_p(p0, p1, pa0, pa1, pa2, pa3); pack_p(p2, p3, pb0, pb1, pb2, pb3); SBAR();
        f32x16 od[2] = {};
        const int cq0 = wq * 32;
        if (U.has_f) { cross_term(od[0], Stf, 2 * wd, qr, r32, hi, lgf2, cq0, true); SBAR(); cross_term(od[1], Stf, 2 * wd + 1, qr, r32, hi, lgf2, cq0, true); SBAR(); }
        if (U.has_b) { cross_term(od[0], Stb, 2 * wd, qr, r32, hi, lgb2, cq0, false); SBAR(); cross_term(od[1], Stb, 2 * wd + 1, qr, r32, hi, lgb2, cq0, false); SBAR(); }
        const int vb = (int)(uintptr_t)Vi + v_rd_base(lane) + wd * 1024;
        pv_one<0>(od[0], vb, pa0, pa1, pa2, pa3); pv_one<1>(od[1], vb, pa0, pa1, pa2, pa3);
        pv_one<0>(od[0], vb + 16384, pb0, pb1, pb2, pb3); pv_one<1>(od[1], vb + 16384, pb0, pb1, pb2, pb3);
        LBAR();
        LAS float* Os = (LAS float*)lds;
#pragma unroll
        for (int dd = 0; dd < 2; ++dd)
#pragma unroll
            for (int r = 0; r < 16; ++r) Os[(wq * 32 + crow(r, hi)) * 132 + 32 * (2 * wd + dd) + r32] = od[dd][r];
        LBAR();
        { const RetUnit UN = ret_unit_of(u + I.G < NU ? u + I.G : u); ret_out_load(a, UN, R, tid); }
        { const LAS float* op = Os + erow * 132 + 32 * eqd;
            f32x4 v[8]; float s = 0.f;
#pragma unroll
            for (int j = 0; j < 8; ++j) { v[j] = *(const LAS f32x4*)(op + 4 * j); s += (v[j].x + v[j].y) + (v[j].z + v[j].w); }
            s += shx(s, 1, lane); s += shx(s, 2, lane);
            const float mu = s * (1.f / HD); float q = 0.f;
#pragma unroll
            for (int j = 0; j < 8; ++j) { v[j] = v[j] - mu; q += (v[j].x * v[j].x + v[j].y * v[j].y) + (v[j].z * v[j].z + v[j].w * v[j].w); }
            q += shx(q, 1, lane); q += shx(q, 2, lane);
            const float rs = 1.f / sqrtf(q * (1.f / HD) + EPS);
            const LAS float* gn = gnt + 32 * eqd;
            bf16* op2 = MIX + (size_t)(U.rowbase + erow) * DM + U.h * HD + 32 * eqd;
#pragma unroll
            for (int j = 0; j < 4; ++j) { float g[8]; unpack8(gw[j], g);
                const f32x4 n0 = *(const LAS f32x4*)(gn + 8 * j), n1 = *(const LAS f32x4*)(gn + 8 * j + 4);
                float y[8];
#pragma unroll
                for (int e = 0; e < 4; ++e) { y[e] = silu_f(g[e]) * (v[2 * j][e] * rs * n0[e]); y[4 + e] = silu_f(g[4 + e]) * (v[2 * j + 1][e] * rs * n1[e]); }
                v4u w; w.x = pk2(y[0], y[1]); w.y = pk2(y[2], y[3]); w.z = pk2(y[4], y[5]); w.w = pk2(y[6], y[7]);
                *(GAS v4u*)(op2 + 8 * j) = w; }
        }
    }
    __syncthreads();
#undef LBAR
}
__device__ __forceinline__ void phase_mix1(ArgP a, LAS unsigned char* lds, int l) {
    a = launder(a); const Ids I = make_ids();
    const int vcu = (I.G % 8 == 0) ? (I.bx % 8) * (I.G / 8) + I.bx / 8 : I.bx;
    for (int s = vcu; s < 256; s += I.G) {
        int pu0, npu, su;
        if (s < 128) { attn_unit<true>(a, lds, l, s, I.tid); pu0 = 3 * s; npu = 3; su = -1; }
        else {
            if (s >= 224) {
                unsigned char* ws = a->ws; const int j = s - 224;
                pg8::Gemm g{(const pg8::bf16_t*)(ws + WS_H), (const pg8::bf16_t*)(ws + WS_WIN) + (size_t)l * DIN * DM, MTOK, DIN, DM};
                pg8::OneUnit S; S.u.pm = 40 + (j & 7); S.u.pn = j >> 3; S.u.half = 0; S.u.h = 0; S.u.part = 0; S.u.slab = 0;
                pg8::EpiIn E{(pg8::bf16_t*)(ws + WS_PROJ), a->out + OUT_CK, a->out + OUT_CV, l, (const float*)(ws + WS_RSS1), (const float*)(ws + WS_SWIN) + (size_t)l * NCOND * DIN};
                pg8::gemm_phase<pg8::EpiIn, pg8::OneUnit, true, true>(lds, g, S, E);
                __syncthreads();
            }
#pragma unroll 1
            for (int k = 0; k < 2; ++k) attn_unit<false>(a, lds, l, 2 * (s - 128) + k, I.tid);
            if (s < 192) { pu0 = 0; npu = 0; su = s - 128; } else if (s < 224) { pu0 = 384 + 4 * (s - 192); npu = 4; su = -1; } else { pu0 = 0; npu = 0; su = -1; }
        }
        __syncthreads();
#pragma unroll 1
        for (int k = (su >= 0 ? -1 : 0); k < npu; ++k) ret_state_unit(a, lds, l, k < 0 ? su : pu0 + k, k < 0, I.tid);
    }
}

__device__ __forceinline__ void filler_convert(ArgP a, LAS unsigned char* lds, int slot) {
    a = launder(a); const Ids I = make_ids();
    const bool all = I.G != 256 || (slot & 1) == 0;
    const int tk = all ? 0 : __builtin_amdgcn_readfirstlane((int)*(LAS const unsigned*)(lds + TK_SLOT));
    if (!(all || tk >= 64)) return;
    const int wi = all ? I.gw : (tk - 64) * 8 + I.wave, nw = all ? I.NGW : 192 * 8;
    constexpr int FSPLIT = I_IN + 512;
    convert_weights(a, lds, 1 + (slot >> 1), (slot & 1) ? FSPLIT : 0, (slot & 1) ? I_LAYER : FSPLIT, wi, nw, I.tid);
    if (slot == 1) convert_weights(a, lds, 0, I_IN + I_OUT, I_IN + I_OUT + I_DN, wi, nw, I.tid);
}
constexpr int NPH_L = 7, PH_FINAL = 3 + DEPTH * NPH_L, NPHASES = PH_FINAL + 1;
__global__ void __launch_bounds__(NWAVES * 64, 2) fwd(Args args) {
    extern __shared__ __attribute__((aligned(16))) unsigned char lds_raw[];
    LAS unsigned char* lds = (LAS unsigned char*)lds_raw;
    ArgP argp = (ArgP)__builtin_amdgcn_kernarg_segment_ptr();
    volatile LAS unsigned* MISC = (volatile LAS unsigned*)(lds + MISC_OFF);
    for (int u = threadIdx.x; u < (LDS_BYTES - 131072) / 4; u += NWAVES * 64) ((LAS unsigned*)(lds + 131072))[u] = 0u;
    __syncthreads();
    tid_publish(threadIdx.x);
    __syncthreads();
    XcdBarrier bar; bar.bar = (unsigned*)(argp->ws + WS_CTL) + CW_BAR; bar.x = 0; bar.st = nullptr;
    bar = xcd_barrier_post((unsigned*)(argp->ws + WS_CTL) + CW_BAR, MISC + 8);
#ifndef PHMASK
#define PHMASK 0xFFFFFFFFu
#endif
#define PHON(b) ((PHMASK >> (b)) & 1u)
#ifndef DUPMASK
#define DUPMASK 0u
#endif
#define DUPON(b) ((DUPMASK >> (b)) & 1u)
#define REP(b) _Pragma("unroll 1") for (int rep_ = 0; rep_ < (DUPON(b) ? 2 : 1); ++rep_)
#define IN(k) true
#ifndef SEAMREP
#define SEAMREP 1
#endif
#define SEAM(k) do { _Pragma("unroll 1") for (int sr_ = 0; sr_ < SEAMREP; ++sr_) xcd_barrier(bar); } while (0)
#define GEMM_SETUP() ArgP ap = launder(argp); unsigned char* ws = ap->ws; int bx = blockIdx.x, G = gridDim.x; asm volatile("" : "+s"(bx), "+s"(G))
    if (PHON(0) && IN(0)) { REP(0) phase_prologue_a(argp, lds); SEAM(0); }
    if (PHON(1) && IN(1)) { REP(1) phase_prologue_b(argp); SEAM(1); }
    if (PHON(2) && IN(2)) { REP(2) phase_prologue_c(argp, lds); SEAM(2); }
    for (int l = 0; l < DEPTH; ++l) {
        const int pb = 3 + l * NPH_L;
        if (PHON(3) && IN(pb + 0)) {
            GEMM_SETUP();
            { const Ids I = make_ids(); zero_f32((float*)(ws + WS_RSS2), MTOK, I.gt, I.NGT); }
            pg8::Gemm g{(const pg8::bf16_t*)(ws + WS_H), (const pg8::bf16_t*)(ws + WS_WIN) + (size_t)l * DIN * DM, MTOK, DIN, DM}; pg8::InMainOrder S; S.init(G, bx);
            pg8::EpiIn E{(pg8::bf16_t*)(ws + WS_PROJ), ap->out + OUT_CK, ap->out + OUT_CV, l, (const float*)(ws + WS_RSS1), (const float*)(ws + WS_SWIN) + (size_t)l * NCOND * DIN};
            REP(3) pg8::gemm_phase<pg8::EpiIn, pg8::InMainOrder, true, true>(lds, g, S, E);
            if (l < 3) filler_convert(argp, lds, 2 * l);
            SEAM(pb + 0);
        }
        if (PHON(4) && IN(pb + 1)) { REP(4) phase_mix1(argp, lds, l); SEAM(pb + 1); }
        if (PHON(5) && IN(pb + 2)) { REP(5) phase_mix2(argp, lds, l); SEAM(pb + 2); }
        if (PHON(6) && IN(pb + 3)) {
            GEMM_SETUP();
            pg8::Gemm g{(const pg8::bf16_t*)(ws + WS_MIX), (const pg8::bf16_t*)(ws + WS_WOUT) + (size_t)l * DM * DM, MTOK, DM, DM}; pg8::TailOrderK S; S.init2(MTOK, DM, G, bx, 256, (float*)(ws + WS_SLAB), (unsigned*)(ws + WS_CTL) + CW_KS, 1u + 2u * (unsigned)l);
            const float* modl = (const float*)(ws + WS_MOD) + (size_t)l * NCOND * NMODC;
            pg8::EpiRes E{l == 0 ? ap->in[0] : (const float*)(ws + WS_X), l == 0 ? ap->in[1] : (const float*)(ws + WS_X) + (size_t)MP * DM, (float*)(ws + WS_X), modl + 2 * DM, modl + 4 * DM, (pg8::bf16_t*)(ws + WS_H), (float*)(ws + WS_RSS2), 0, (const float*)(ws + WS_SLAB)};
            REP(6) { E.dry = (DUPON(6) && rep_ == 0); pg8::gemm_phase<pg8::EpiRes, pg8::TailOrderK, true, true>(lds, g, S, E); }
            SEAM(pb + 3);
        }
        if (PHON(8) && IN(pb + 4)) {
            GEMM_SETUP();
            { const Ids I = make_ids(); zero_f32((float*)(ws + WS_RSS1), MTOK, I.gt, I.NGT); }
            pg8::Gemm g{(const pg8::bf16_t*)(ws + WS_H), (const pg8::bf16_t*)(ws + WS_WUP) + (size_t)l * DUP * DM, MTOK, DUP, DM}; pg8::TailOrderDyn S; S.init2(MTOK, DUP, G, bx, 2048, (unsigned*)(ws + WS_CTL) + CW_TK + 16 * l, (PG8_LAS unsigned*)(lds + TK_SLOT));
            pg8::EpiUpConv E{(pg8::bf16_t*)(ws + WS_ACT), (const float*)(ws + WS_RSS2), (const float*)(ws + WS_SWUP) + (size_t)l * NCOND * DUP, ap->in[15] + (size_t)l * 3 * DUP, ap->in[16] + (size_t)l * DUP, (float*)(ws + WS_HALO), (PG8_LAS float*)(lds + EX_OFF)};
            REP(8) pg8::gemm_phase<pg8::EpiUpConv, pg8::TailOrderDyn, true, true>(lds, g, S, E);
            if (l < 3) filler_convert(argp, lds, 2 * l + 1);
            SEAM(pb + 4);
        }
        if (PHON(9) && IN(pb + 5)) { REP(9) phase_convfix(argp, l); SEAM(pb + 5); }
        if (PHON(10) && IN(pb + 6)) {
            GEMM_SETUP();
            pg8::Gemm g{(const pg8::bf16_t*)(ws + WS_ACT), (const pg8::bf16_t*)(ws + WS_WDN) + (size_t)l * DM * DFF, MTOK, DM, DFF}; pg8::TailOrderK S; S.init2(MTOK, DM, G, bx, 256, (float*)(ws + WS_SLAB), (unsigned*)(ws + WS_CTL) + CW_KS, 2u + 2u * (unsigned)l);
            const float* modl = (const float*)(ws + WS_MOD) + (size_t)l * NCOND * NMODC;
            pg8::EpiRes E{(const float*)(ws + WS_X), (const float*)(ws + WS_X) + (size_t)MP * DM, (float*)(ws + WS_X), modl + 5 * DM, l + 1 < DEPTH ? modl + NCOND * NMODC + DM : nullptr, (pg8::bf16_t*)(ws + WS_H), (float*)(ws + WS_RSS1), 0, (const float*)(ws + WS_SLAB)};
            REP(10) { E.dry = (DUPON(10) && rep_ == 0); pg8::gemm_phase<pg8::EpiRes, pg8::TailOrderK, true, true>(lds, g, S, E); }
            SEAM(pb + 6);
        }
    }
    if (PHON(11) && IN(PH_FINAL)) { REP(11) phase_final(argp); }
#undef IN
#undef SEAM
}

#ifndef N_LAUNCH_MODE
#define N_LAUNCH_MODE 1
#endif
extern "C" void kernel_launch(void* const* d_in, const int* in_sizes, int n_in, void* d_out, int out_size, void* d_ws, size_t ws_size, hipStream_t stream) {
    static int grid = 0;
    if (grid == 0) {
        if (n_in != 19 || (size_t)out_size != OUT_TOTAL || ws_size < WS_END) { fprintf(stderr, "kernel_launch: shape mismatch: n_in %d out %d ws %zu (need %zu)\n", n_in, out_size, ws_size, (size_t)WS_END); grid = -1; return; }
        int dev = 0, cus = 0, per_cu = 0;
        if (hipGetDevice(&dev) != hipSuccess || hipDeviceGetAttribute(&cus, hipDeviceAttributeMultiprocessorCount, dev) != hipSuccess) { grid = -1; return; }
        if (hipFuncSetAttribute((const void*)fwd, hipFuncAttributeMaxDynamicSharedMemorySize, LDS_BYTES) != hipSuccess) { fprintf(stderr, "kernel_launch: hipFuncSetAttribute failed\n"); grid = -1; return; }
        if (hipOccupancyMaxActiveBlocksPerMultiprocessor(&per_cu, (const void*)fwd, NWAVES * 64, LDS_BYTES) != hipSuccess || per_cu < 1) fprintf(stderr, "kernel_launch: occupancy query says %d\n", per_cu);
        (void)hipGetLastError();
        grid = cus;
    }
    if (grid < 0) return;
    if (hipMemsetAsync((char*)d_ws + WS_CTL, 0, CTL_ZERO_BYTES, stream) != hipSuccess) return;
    Args a{};
    for (int i = 0; i < 19; ++i) a.in[i] = (const float*)d_in[i];
    a.out = (float*)d_out; a.ws = (unsigned char*)d_ws;
    a.ph_lo = 0; a.ph_hi = NPHASES;
    hipLaunchKernelGGL(fwd, dim3(grid), dim3(NWAVES * 64), LDS_BYTES, stream, a);
    const hipError_t le = hipPeekAtLastError();
    if (le != hipSuccess) fprintf(stderr, "kernel_launch: launch failed: %s\n", hipGetErrorName(le));
}
```
